# Optimizing an MI355X kernel written in HIP

```python
import jax, jax.numpy as jnp
from jax import lax
import numpy as np

D_MODEL = 2048
BATCH = 8
SEQ = 2048
DEPTH = 4
DEC_BATCH = 32
DEC_SEQ = 16
PAST_LEN = 2048

CHUNK = 64
N_BRANCH = 4
BRANCH_W = D_MODEL // 4
RET_HEADS = 4
RET_DV = BRANCH_W // RET_HEADS
RET_DK = RET_DV // 2
ROPE_BASE = 10000.0
CONV_W = 3
GMLP_BLOCK = 128
GMLP_GROUPS = 4
GMLP_GC = BRANCH_W // GMLP_GROUPS
ATT_HEADS = 8
ATT_DH = BRANCH_W // ATT_HEADS
ATT_LEFT_CHUNKS = 8
ATT_BAND = ATT_LEFT_CHUNKS * CHUNK
MAX_REL = 128
NORM_EPS = 1e-6
IN_COLS = 2 * RET_HEADS * RET_DK + 13 * BRANCH_W + N_BRANCH * D_MODEL

kernel_name = "hybrid_streaming_encoder_step"


def split_in(h):
    bw = BRANCH_W
    sizes = (RET_HEADS * RET_DK, RET_HEADS * RET_DK, bw, bw,
             bw, bw, bw, bw,
             bw, bw, bw,
             bw, bw, bw, bw,
             N_BRANCH * D_MODEL)
    idx = np.cumsum(sizes)[:-1].tolist()
    return jnp.split(h, idx, axis=-1)


def rms_norm(x, g):
    xf = x.astype(jnp.float32)
    y = xf * lax.rsqrt(jnp.mean(xf * xf, axis=-1, keepdims=True) + NORM_EPS)
    return (y * g.astype(jnp.float32)).astype(x.dtype)


def layer_norm(x, g, b):
    xf = x.astype(jnp.float32)
    mu = jnp.mean(xf, axis=-1, keepdims=True)
    xc = xf - mu
    var = jnp.mean(xc * xc, axis=-1, keepdims=True)
    return (xc * lax.rsqrt(var + NORM_EPS) * g.astype(jnp.float32) + b.astype(jnp.float32)).astype(x.dtype)


def head_norm(o):
    of = o.astype(jnp.float32)
    mu = jnp.mean(of, axis=-1, keepdims=True)
    oc = of - mu
    var = jnp.mean(oc * oc, axis=-1, keepdims=True)
    return (oc * lax.rsqrt(var + NORM_EPS)).astype(o.dtype)


def rotary(x, pos):
    half = x.shape[-1] // 2
    freqs = ROPE_BASE ** (-jnp.arange(half, dtype=jnp.float32) / half)
    ang = pos.astype(jnp.float32)[:, None] * freqs[None, :]
    cos = jnp.cos(ang)[None, :, None, :]
    sin = jnp.sin(ang)[None, :, None, :]
    xf = x.astype(jnp.float32)
    x1, x2 = xf[..., :half], xf[..., half:]
    return jnp.concatenate([x1 * cos - x2 * sin, x1 * sin + x2 * cos], axis=-1).astype(x.dtype)


def retention_log_gamma():
    return jnp.log1p(-jnp.exp2(-5.0 - jnp.arange(RET_HEADS, dtype=jnp.float32)))


def retention_block(q, k, v, s_prev):
    L = q.shape[1]
    lg = retention_log_gamma()
    t = jnp.arange(L, dtype=jnp.float32)
    diff = t[:, None] - t[None, :]
    decay = jnp.where(diff >= 0, jnp.exp(jnp.maximum(diff, 0.0)[None] * lg[:, None, None]), 0.0).astype(q.dtype)
    q_decay = jnp.exp((t[None, :] + 1.0) * lg[:, None]).astype(q.dtype)
    k_decay = jnp.exp((L - 1.0 - t)[None, :] * lg[:, None]).astype(q.dtype)
    blk_decay = jnp.exp(L * lg).astype(q.dtype)
    inner = jnp.einsum('blhk,bmhk->bhlm', q, k) * decay[None]
    o = jnp.einsum('bhlm,bmhv->blhv', inner, v) + jnp.einsum('blhk,hl,bhkv->blhv', q, q_decay, s_prev)
    s_new = blk_decay[None, :, None, None] * s_prev + jnp.einsum('blhk,hl,blhv->bhkv', k, k_decay, v)
    return o, s_new


def retention_prompt(q, k, v):
    B, T, H, dk = q.shape
    dv = v.shape[-1]
    nc = T // CHUNK

    def to_chunks(a):
        return jnp.moveaxis(a.reshape(B, nc, CHUNK, H, a.shape[-1]), 1, 0)

    def step(s, qkv):
        o, s_new = retention_block(qkv[0], qkv[1], qkv[2], s)
        return s_new, o

    s0 = jnp.zeros((B, H, dk, dv), q.dtype)
    s_final, o = lax.scan(step, s0, (to_chunks(q), to_chunks(k), to_chunks(v)))
    return jnp.moveaxis(o, 0, 1).reshape(B, T, H, dv), s_final


def short_conv(z_ext, w):
    T = z_ext.shape[1] - (CONV_W - 1)
    y = w[0] * z_ext[:, 0:T]
    for i in range(1, CONV_W):
        y = y + w[i] * z_ext[:, i:i + T]
    return y


def gmlp_spatial(vn, ws, bs):
    L = vn.shape[2]
    pos = jnp.arange(L)
    mask = (pos[None, :] // CHUNK) <= (pos[:, None] // CHUNK)
    w = jnp.where(mask[None], ws[:, :L, :L], 0.0).astype(vn.dtype)
    return jnp.einsum('gij,bnjgc->bnigc', w, vn) + bs[:, :L].T[None, None, :, :, None]


def chunk_attention(q, k, v, rel, valid, table):
    s = jnp.einsum('bnqhd,bnkhd->bhnqk', q, k).astype(jnp.float32) * (ATT_DH ** -0.5)
    bias = table[:, jnp.clip(rel, -MAX_REL, MAX_REL) + MAX_REL].astype(jnp.float32)
    s = s + bias[None, :, None]
    s = jnp.where(valid[None, None], s, -1e30)
    p = jax.nn.softmax(s, axis=-1).astype(v.dtype)
    return jnp.einsum('bhnqk,bnkhd->bnqhd', p, v)


def merge_out(x, branches, gate_logits, w_branch, w_out):
    B, T, _ = x.shape
    gates = jax.nn.sigmoid(gate_logits.astype(jnp.float32)).astype(x.dtype).reshape(B, T, N_BRANCH, D_MODEL)
    h = gates[:, :, 0] * (branches[0] @ w_branch[0])
    for i in range(1, N_BRANCH):
        h = h + gates[:, :, i] * (branches[i] @ w_branch[i])
    return x + h @ w_out


def layer_prompt(x, gain, w_in, w_branch, w_out, conv_w, ln_g, ln_b, ws, bs, rel_table):
    B, T, _ = x.shape
    (rq, rk, rv, rg, cb, cc, cx, cg, mu, mv, mg, aq, ak, av, ag, gl) = split_in(rms_norm(x, gain) @ w_in)
    pos = jnp.arange(T)
    rq = rotary(rq.reshape(B, T, RET_HEADS, RET_DK), pos)
    rk = rotary(rk.reshape(B, T, RET_HEADS, RET_DK), pos) * (RET_DK ** -0.5)
    o_ret, s_ret = retention_prompt(rq, rk, rv.reshape(B, T, RET_HEADS, RET_DV))
    br_a = jax.nn.silu(rg) * head_norm(o_ret).reshape(B, T, BRANCH_W)
    z = cc * cx
    z_ext = jnp.pad(z, ((0, 0), (CONV_W - 1, 0), (0, 0)))
    br_b = jax.nn.silu(cg) * (cb * short_conv(z_ext, conv_w))
    conv_state = z_ext[:, -(CONV_W - 1):]
    vn = layer_norm(mv, ln_g, ln_b)
    mix = gmlp_spatial(vn.reshape(B, T // GMLP_BLOCK, GMLP_BLOCK, GMLP_GROUPS, GMLP_GC), ws, bs).reshape(B, T, BRANCH_W)
    br_c = jax.nn.silu(mg) * (mu * mix)
    nc = T // CHUNK
    q = aq.reshape(B, nc, CHUNK, ATT_HEADS, ATT_DH)
    k = ak.reshape(B, T, ATT_HEADS, ATT_DH)
    v = av.reshape(B, T, ATT_HEADS, ATT_DH)
    pad = ((0, 0), (ATT_BAND, 0), (0, 0), (0, 0))
    kp, vp = jnp.pad(k, pad), jnp.pad(v, pad)
    band = ATT_BAND + CHUNK
    idx = (jnp.arange(nc) * CHUNK)[:, None] + jnp.arange(band)[None, :]
    kb, vb = kp[:, idx], vp[:, idx]
    rel = jnp.arange(CHUNK)[:, None] - jnp.arange(band)[None, :] + ATT_BAND
    valid = (idx >= ATT_BAND)[:, None, :]
    o_att = chunk_attention(q, kb, vb, rel, valid, rel_table).reshape(B, T, BRANCH_W)
    br_d = jax.nn.silu(ag) * o_att
    keep = min(ATT_BAND, T)
    x = merge_out(x, (br_a, br_b, br_c, br_d), gl, w_branch, w_out)
    return x, s_ret, conv_state, k[:, T - keep:], v[:, T - keep:]


def layer_sample(x, ret_s, conv_s, cache_k, cache_v, gain, w_in, w_branch, w_out, conv_w, ln_g, ln_b, ws, bs, rel_table):
    B, L, _ = x.shape
    (rq, rk, rv, rg, cb, cc, cx, cg, mu, mv, mg, aq, ak, av, ag, gl) = split_in(rms_norm(x, gain) @ w_in)
    pos = PAST_LEN + jnp.arange(L)
    rq = rotary(rq.reshape(B, L, RET_HEADS, RET_DK), pos)
    rk = rotary(rk.reshape(B, L, RET_HEADS, RET_DK), pos) * (RET_DK ** -0.5)
    o_ret, s_ret = retention_block(rq, rk, rv.reshape(B, L, RET_HEADS, RET_DV), ret_s)
    br_a = jax.nn.silu(rg) * head_norm(o_ret).reshape(B, L, BRANCH_W)
    z = cc * cx
    z_ext = jnp.concatenate([conv_s.astype(z.dtype), z], axis=1)
    br_b = jax.nn.silu(cg) * (cb * short_conv(z_ext, conv_w))
    conv_state = z_ext[:, -(CONV_W - 1):]
    vn = layer_norm(mv, ln_g, ln_b)
    mix = gmlp_spatial(vn.reshape(B, 1, L, GMLP_GROUPS, GMLP_GC), ws, bs).reshape(B, L, BRANCH_W)
    br_c = jax.nn.silu(mg) * (mu * mix)
    W = cache_k.shape[1]
    q = aq.reshape(B, 1, L, ATT_HEADS, ATT_DH)
    k = ak.reshape(B, L, ATT_HEADS, ATT_DH)
    v = av.reshape(B, L, ATT_HEADS, ATT_DH)
    kk = jnp.concatenate([cache_k.astype(k.dtype), k], axis=1)[:, None]
    vv = jnp.concatenate([cache_v.astype(v.dtype), v], axis=1)[:, None]
    rel = jnp.arange(L)[:, None] - jnp.arange(W + L)[None, :] + W
    valid = jnp.ones((1, 1, W + L), dtype=bool)
    o_att = chunk_attention(q, kk, vv, rel, valid, rel_table).reshape(B, L, BRANCH_W)
    br_d = jax.nn.silu(ag) * o_att
    x = merge_out(x, (br_a, br_b, br_c, br_d), gl, w_branch, w_out)
    return x, s_ret, conv_state, vn, k, v


def setup_inputs(seed: int = 0) -> dict:
    key = jax.random.key(seed)
    ks = jax.random.split(key, 17)
    f32 = jnp.float32
    win_rows = min(ATT_BAND, PAST_LEN)
    n = lambda k, s: jax.random.normal(k, s, f32)
    return {
        "x_prompt": n(ks[0], (BATCH, SEQ, D_MODEL)),
        "x_sample": n(ks[1], (DEC_BATCH, DEC_SEQ, D_MODEL)),
        "state_ret": n(ks[2], (DEPTH, DEC_BATCH, RET_HEADS, RET_DK, RET_DV)),
        "state_conv": n(ks[3], (DEPTH, DEC_BATCH, CONV_W - 1, BRANCH_W)),
        "cache_att_k": n(ks[4], (DEPTH, DEC_BATCH, win_rows, ATT_HEADS, ATT_DH)),
        "cache_att_v": n(ks[5], (DEPTH, DEC_BATCH, win_rows, ATT_HEADS, ATT_DH)),
        "norm_gain": 1.0 + 0.01 * n(ks[6], (DEPTH, D_MODEL)),
        "w_in": n(ks[7], (DEPTH, D_MODEL, IN_COLS)) * (D_MODEL ** -0.5),
        "w_branch": n(ks[8], (DEPTH, N_BRANCH, BRANCH_W, D_MODEL)) * (BRANCH_W ** -0.5),
        "w_out": n(ks[9], (DEPTH, D_MODEL, D_MODEL)) * (D_MODEL ** -0.5),
        "conv_w": n(ks[10], (DEPTH, CONV_W, BRANCH_W)) * (CONV_W ** -0.5),
        "gmlp_ln_gain": 1.0 + 0.01 * n(ks[11], (DEPTH, BRANCH_W)),
        "gmlp_ln_bias": 0.01 * n(ks[12], (DEPTH, BRANCH_W)),
        "gmlp_ws": 0.5 * n(ks[13], (DEPTH, GMLP_GROUPS, GMLP_BLOCK, GMLP_BLOCK)) * (GMLP_BLOCK ** -0.5),
        "gmlp_bs": 1.0 + 0.1 * n(ks[14], (DEPTH, GMLP_GROUPS, GMLP_BLOCK)),
        "att_rel_bias": 0.5 * n(ks[15], (DEPTH, ATT_HEADS, 2 * MAX_REL + 1)),
        "final_norm_gain": 1.0 + 0.01 * n(ks[16], (D_MODEL,)),
    }


def reference(x_prompt, x_sample, state_ret, state_conv, cache_att_k, cache_att_v, norm_gain, w_in, w_branch,
              w_out, conv_w, gmlp_ln_gain, gmlp_ln_bias, gmlp_ws, gmlp_bs, att_rel_bias, final_norm_gain):
    p_ret, p_conv, p_k, p_v = [], [], [], []
    s_ret, s_conv, s_k, s_v, s_gv = [], [], [], [], []
    hp = x_prompt
    hs = x_sample
    for l in range(DEPTH):
        lw = (norm_gain[l], w_in[l], w_branch[l], w_out[l], conv_w[l], gmlp_ln_gain[l], gmlp_ln_bias[l],
              gmlp_ws[l], gmlp_bs[l], att_rel_bias[l])
        hp, a, b, c, d = layer_prompt(hp, *lw)
        p_ret.append(a); p_conv.append(b); p_k.append(c); p_v.append(d)
        hs, a, b, c, d, e = layer_sample(hs, state_ret[l], state_conv[l], cache_att_k[l], cache_att_v[l], *lw)
        s_ret.append(a); s_conv.append(b); s_gv.append(c); s_k.append(d); s_v.append(e)
    y_prompt = rms_norm(hp, final_norm_gain)
    y_sample = rms_norm(hs, final_norm_gain)
    return (y_prompt, y_sample,
            jnp.stack(p_ret), jnp.stack(p_conv), jnp.stack(p_k), jnp.stack(p_v),
            jnp.stack(s_ret), jnp.stack(s_conv), jnp.stack(s_k), jnp.stack(s_v), jnp.stack(s_gv))
```

```cpp
#include <hip/hip_runtime.h>
#include <cstdio>
#include <cstdint>
#include <type_traits>

#ifndef MK_SPLIT
#define MK_SPLIT 0
#endif

#define GAS __attribute__((address_space(1)))
#define LAS __attribute__((address_space(3)))
typedef unsigned short bf16;
typedef unsigned char uchar;
typedef unsigned u32x4 __attribute__((ext_vector_type(4)));
typedef unsigned u32x2 __attribute__((ext_vector_type(2)));
typedef float f32x4 __attribute__((ext_vector_type(4)));
typedef float f32x2 __attribute__((ext_vector_type(2)));
typedef float f32x16 __attribute__((ext_vector_type(16)));
typedef short bf16x8 __attribute__((ext_vector_type(8)));
typedef GAS unsigned gu32;
typedef int i32x4 __attribute__((ext_vector_type(4)));

constexpr int DM = 2048, NB = 8, SEQ = 2048, DEPTH = 4, DB = 32, DS = 16;
constexpr int MP = NB * SEQ, MS = DB * DS, MT = MP + MS;
constexpr int HP = 15360;
constexpr int C_AK = 0, C_AV = 512, C_MV = 1024, C_CC = 1536, C_CX = 2048, C_RQ = 2560, C_RK = 2816, C_RV = 3072, C_CB = 3584, C_MU = 4096, C_AQ = 4608,
              C_RG = 5120, C_CG = 5632, C_MG = 6144, C_AG = 6656, C_GL = 7168;
constexpr int NBF = 5120, NQ = HP - NBF, NQM = C_GL - NBF;
__host__ __device__ __forceinline__ int in_pos(int n) {
    const int b2 = n >> 9, nb = 2 * (int)((0xD109C28B437A65ULL >> (4 * b2)) & 15ULL) + ((n >> 8) & 1);
    return nb * 256 + (n & 255);
}
constexpr float NORM_EPS = 1e-6f;
constexpr float LOG2E = 1.4426950408889634f;
constexpr size_t O_Y = 0, O_PRET = 34603008, O_PCONV = 35651584, O_PK = 35684352, O_PV = 44072960, O_SRET = 52461568,
                 O_SCONV = 56655872, O_SK = 56786944, O_SV = 57835520, O_SGV = 58884096, O_END = 59932672;
constexpr size_t MiB = 1u << 20;
constexpr size_t WS_CTL = 0, CTL_ZERO_BYTES = 1 * MiB;
constexpr size_t WS_WIN = 2 * MiB, WS_WB = 242 * MiB, WS_WO = 274 * MiB, WS_XN = 306 * MiB, WS_BR = 372 * MiB, WS_H2 = 438 * MiB,
                 WS_U = 504 * MiB, WS_SB = 536 * MiB, WS_XP = 552 * MiB, WS_X = 584 * MiB, WS_H = 716 * MiB, WS_MP = 1211 * MiB, WS_SSQP = 1227 * MiB, WS_RB = 1230 * MiB, WS_END = 1495 * MiB;
static_assert(WS_WIN + (size_t)DEPTH * HP * DM * 2 <= WS_WB && WS_XN + (size_t)MT * DM * 2 <= WS_BR && WS_H + (size_t)MT * HP * 2 <= WS_END, "ws map");
constexpr int CW_BAR = 4096;
constexpr int CW_Q = 16384;
constexpr int CW_CMAX = 135168;
constexpr int CW_SSQ = 65536;
static_assert(CW_SSQ + DEPTH * MT <= CW_CMAX && (CW_CMAX + DEPTH * NQ) * 4 <= (int)CTL_ZERO_BYTES && (CW_SSQ + DEPTH * MT) * 4 <= (int)CTL_ZERO_BYTES, "SSQ inside the zeroed control region");
constexpr int RING_BYTES = 131072, LDSCTL_OFF = RING_BYTES, MISC_OFF = LDSCTL_OFF + 320, LDS_BYTES = 147456;
constexpr int NWAVES = 8, NTHR = 512;
constexpr size_t WS_XQ = 584 * MiB, WS_SW = 620 * MiB, WS_RS = 621 * MiB;
static_assert(WS_XQ + (size_t)MT * DM <= WS_SW && WS_RS + (size_t)DEPTH * MT * 4 <= 716 * MiB, "int8 buffers");

__device__ __forceinline__ float bflo(unsigned u) { return __builtin_bit_cast(float, u << 16); }
__device__ __forceinline__ float bfhi(unsigned u) { return __builtin_bit_cast(float, u & 0xffff0000u); }
__device__ __forceinline__ float bf2f(bf16 b) { return __builtin_bit_cast(float, (unsigned)b << 16); }
__device__ __forceinline__ unsigned pk2(float lo, float hi) { unsigned r; asm("v_cvt_pk_bf16_f32 %0, %1, %2" : "=v"(r) : "v"(lo), "v"(hi)); return r; }
__device__ __forceinline__ bf16 f2bf(float f) { return (bf16)(pk2(f, 0.f) & 0xffffu); }
__device__ __forceinline__ float ex2(float x) { return __builtin_amdgcn_exp2f(x); }
__device__ __forceinline__ float fexp(float x) { return __builtin_amdgcn_exp2f(x * LOG2E); }
__device__ __forceinline__ float sigm(float x) { return __builtin_amdgcn_rcpf(1.f + fexp(-x)); }
__device__ __forceinline__ float silu(float x) { return x * sigm(x); }
__device__ __forceinline__ float wave_sum(float v) {
#pragma unroll
    for (int o = 1; o < 64; o <<= 1) v += __shfl_xor(v, o);
    return v;
}
__device__ __forceinline__ float wave_max(float v) {
#pragma unroll
    for (int o = 1; o < 64; o <<= 1) v = fmaxf(v, __shfl_xor(v, o));
    return v;
}
#define MFMA32(a, b, c) __builtin_amdgcn_mfma_f32_32x32x16_bf16((a), (b), (c), 0, 0, 0)
__device__ __forceinline__ bf16x8 ldfrag(const LAS uchar* base, int pitch, int row0, int k0, int lane) {
    return *(const LAS bf16x8*)(base + (row0 + (lane & 31)) * pitch + (k0 + 8 * (lane >> 5)) * 2);
}
__device__ __forceinline__ bf16x8 ldfrag_perm(const LAS uchar* base, int pitch, int row0, int kb, int lane) {
    const LAS uchar* p = base + (row0 + (lane & 31)) * pitch + (kb + 4 * (lane >> 5)) * 2;
    const u32x2 lo = *(const LAS u32x2*)p, hi = *(const LAS u32x2*)(p + 16);
    return __builtin_bit_cast(bf16x8, (u32x4){lo.x, lo.y, hi.x, hi.y});
}
template <int SH> __device__ __forceinline__ bf16x8 ldfrag_sw(const LAS uchar* base, int pitch, int row0, int k0, int lane) {
    const int r = row0 + (lane & 31), k = (k0 + 8 * (lane >> 5)) ^ (((r >> SH) & 7) << 3);
    return *(const LAS bf16x8*)(base + r * pitch + k * 2);
}
template <int SH> __device__ __forceinline__ bf16x8 ldfrag_perm_sw(const LAS uchar* base, int pitch, int row0, int kb, int lane) {
    const int r = row0 + (lane & 31), sw = ((r >> SH) & 7) << 3, kk = kb + 4 * (lane >> 5);
    const u32x2 lo = *(const LAS u32x2*)(base + r * pitch + (kk ^ sw) * 2), hi = *(const LAS u32x2*)(base + r * pitch + ((kk + 8) ^ sw) * 2);
    return __builtin_bit_cast(bf16x8, (u32x4){lo.x, lo.y, hi.x, hi.y});
}
__device__ __forceinline__ bf16x8 acc_frag(const f32x16& x, int s) {
    u32x4 w;
    if (s == 0) { w.x = pk2(x[0], x[1]); w.y = pk2(x[2], x[3]); w.z = pk2(x[4], x[5]); w.w = pk2(x[6], x[7]); }
    else        { w.x = pk2(x[8], x[9]); w.y = pk2(x[10], x[11]); w.z = pk2(x[12], x[13]); w.w = pk2(x[14], x[15]); }
    return __builtin_bit_cast(bf16x8, w);
}
__device__ __forceinline__ void rot_cs(int pos, int i, float& c, float& s) {
    const float fr = ex2(-(float)i * (13.287712379549449f / 32.f));
    float rev = ((float)pos * fr) * 0.15915494309189535f;
    rev = rev - rintf(rev);
    c = __builtin_amdgcn_cosf(rev); s = __builtin_amdgcn_sinf(rev);
}

namespace pg8 {
#define PG8_LAS __attribute__((address_space(3)))
typedef unsigned short bf16_t;
constexpr int BM = 256, BK = 64, HALF = 128, HTB = HALF * BK * 2, NXCD = 8, WGM = 4;
__host__ __device__ __forceinline__ int lds_byte(int r, int c) { const int st = (r >> 4) * 2 + (c >> 5), rr = r & 15, cc = c & 31, ob = rr * 64 + cc * 2; return st * 1024 + (ob ^ (((ob >> 9) & 1) << 5)); }
__host__ __device__ __forceinline__ void stage_rc(int b, int& R, int& C) { const int st = b / 1024, sb = b % 1024, swz = sb ^ (((sb >> 9) & 1) << 5); R = (st >> 1) * 16 + swz / 64; C = (st & 1) * 32 + (swz % 64) / 2; }
__host__ __device__ __forceinline__ int perm32(int rho) { const int n = rho >> 4, i = rho & 15; return 8 * (i >> 2) + 4 * n + (i & 3); }

struct Unit { int pm, pn, seg, nt, mode; };
struct Gemm { const void* A; const void* Bt; int K; int segb; };

struct SegOrder {
    int nM, nN, nwg, G, c, nseg, nt;
    __device__ void init(int M, int N, int G_, int c_, int nseg_, int nt_) { nM = M / BM; nN = N / BM; nwg = nM * nN; G = G_; c = c_; nseg = nseg_; nt = nt_; }
    __device__ __forceinline__ bool next(int i, Unit& u) const {
        const int ti = i / nseg; u.seg = i - ti * nseg; u.nt = nt; u.mode = 0;
        const long L = (long)ti * G + c; if (L >= nwg) return false;
        int wgid = (int)L; { const int q = nwg / NXCD, r = nwg % NXCD, xcd = wgid % NXCD, off = wgid / NXCD; wgid = (xcd < r ? xcd * (q + 1) : r * (q + 1) + (xcd - r) * q) + off; }
        const int nig = WGM * nN, gid = wgid / nig, fm = gid * WGM, gsz = (nM - fm) < WGM ? (nM - fm) : WGM;
        u.pm = fm + ((wgid % nig) % gsz); u.pn = (wgid % nig) / gsz; return true;
    }
};

struct OneTile {
    int pm, pn, nseg, nt;
    __device__ __forceinline__ bool next(int i, Unit& u) const { if (i >= nseg) return false; int a = pm, b = pn; asm volatile("" : "+s"(a), "+s"(b));
        u.pm = a; u.pn = b; u.seg = i; u.nt = nt; u.mode = 0; return true; }
};
struct OneUnit {
    int pm, pn, seg, nt;
    __device__ __forceinline__ bool next(int i, Unit& u) const { if (i >= 1) return false; int a = pm, b = pn; asm volatile("" : "+s"(a), "+s"(b)); u.pm = a; u.pn = b; u.seg = seg; u.nt = nt; u.mode = 0; return true; }
};
struct OutOrder {
    SegOrder P; int nP, c;
    __device__ __forceinline__ bool next(int i, Unit& u) const {
        Unit t; const bool okp = P.next(i < nP ? i : 0, t);
        int a = MP / BM + (c >> 6), b = (c >> 3) & 7; asm volatile("" : "+s"(a), "+s"(b));
        const bool pr = (i < nP);
        Unit r; r.pm = pr ? t.pm : a; r.pn = pr ? t.pn : b; r.seg = pr ? 0 : (c & 7); r.nt = pr ? t.nt : 4; r.mode = pr ? 0 : 1;
        u = r;
        return pr ? okp : (i == nP && c < 128);
    }
};
struct EpiH {
    bf16* H; const float* ssq;
    static __device__ __forceinline__ bool keep(const Unit&) { return false; }
    __device__ __forceinline__ void operator()(f32x4 (&acc)[2][2][4][2], const Unit& u, int wr, int wc, int fr, int fq) const {
        const int row0 = u.pm * BM + wr * 64 + fr, col0 = u.pn * BM + wc * 32 + 8 * fq;
        float rs[2][4];
#pragma unroll
        for (int ai = 0; ai < 2; ++ai)
#pragma unroll
            for (int m = 0; m < 4; ++m) rs[ai][m] = ssq[row0 + ai * HALF + m * 16];
#pragma unroll
        for (int ai = 0; ai < 2; ++ai)
#pragma unroll
            for (int m = 0; m < 4; ++m) rs[ai][m] = __builtin_amdgcn_rsqf(rs[ai][m] * (1.f / DM) + NORM_EPS);
#pragma unroll
        for (int ai = 0; ai < 2; ++ai)
#pragma unroll
            for (int m = 0; m < 4; ++m) { bf16* rowp = H + (size_t)(row0 + ai * HALF + m * 16) * HP + col0;
#pragma unroll
                for (int bj = 0; bj < 2; ++bj) { const f32x4 v0 = acc[ai][bj][m][0] * rs[ai][m], v1 = acc[ai][bj][m][1] * rs[ai][m];
                    u32x4 w; w.x = pk2(v0[0], v0[1]); w.y = pk2(v0[2], v0[3]); w.z = pk2(v1[0], v1[1]); w.w = pk2(v1[2], v1[3]);
                    *(u32x4*)(rowp + bj * HALF) = w; } }
    }
};
template <bool SMP> struct EpiHqT {
    bf16* H; const float* rsc; const float* sw; bf16* RB;
    static __device__ __forceinline__ bool keep(const Unit&) { return false; }
    __device__ __forceinline__ void operator()(i32x4 (&acc)[2][2][4][2], const Unit& u, int wr, int wc, int fr, int fq) const {
        const int row0 = u.pm * BM + wr * 64 + fr;
        float rs[2][4];
#pragma unroll
        for (int ai = 0; ai < 2; ++ai)
#pragma unroll
            for (int m = 0; m < 4; ++m) rs[ai][m] = rsc[row0 + ai * HALF + m * 16];
        f32x4 cs[2][2];
#pragma unroll
        for (int bj = 0; bj < 2; ++bj) { const float* sp = sw + u.pn * BM + bj * HALF + wc * 32 + 8 * fq; cs[bj][0] = *(const f32x4*)sp; cs[bj][1] = *(const f32x4*)(sp + 4); }
        if (u.pn < NQM / BM) {
#pragma unroll
            for (int ai = 0; ai < 2; ++ai)
#pragma unroll
                for (int m = 0; m < 4; ++m) { bf16* rowp = H + (size_t)(row0 + ai * HALF + m * 16) * HP + NBF + u.pn * BM + wc * 32 + 8 * fq;
#pragma unroll
                    for (int bj = 0; bj < 2; ++bj) { const i32x4 q0 = acc[ai][bj][m][0], q1 = acc[ai][bj][m][1]; const f32x4 s0 = cs[bj][0] * rs[ai][m], s1 = cs[bj][1] * rs[ai][m];
                        u32x4 w; w.x = pk2((float)q0[0] * s0[0], (float)q0[1] * s0[1]); w.y = pk2((float)q0[2] * s0[2], (float)q0[3] * s0[3]);
                        w.z = pk2((float)q1[0] * s1[0], (float)q1[1] * s1[1]); w.w = pk2((float)q1[2] * s1[2], (float)q1[3] * s1[3]);
                        *(u32x4*)(rowp + bj * HALF) = w; } }
            return;
        }
        const int t28 = u.pn - NQM / BM, up = fq >> 1;
        const int nb = t28 * 64 + wc * 16 + (fq & 1) * 8;
        const size_t rb0 = (size_t)(u.pm * 8 + (t28 >> 2)) * 262144 + (size_t)(wr * 4 + (t28 & 1) * 2 + (wc >> 1)) * 8192 + ((t28 >> 1) & 1) * 512 + (((wc & 1) * 2 + (fq & 1)) * 16 + fr) * 8;
        constexpr bool smp = SMP;
#pragma unroll
        for (int ai = 0; ai < 2; ++ai)
#pragma unroll
            for (int m = 0; m < 4; ++m) {
                float R[4][4];
#pragma unroll
                for (int c = 0; c < 4; ++c) { const i32x4 q = acc[ai][c >> 1][m][c & 1]; const f32x4 sc = cs[c >> 1][c & 1] * (rs[ai][m] * -LOG2E);
                    float a[4];
#pragma unroll
                    for (int k = 0; k < 4; ++k) a[k] = 1.f + ex2(__builtin_amdgcn_fmed3f((float)q[k] * sc[k], -30.f * LOG2E, 30.f * LOG2E));
                    if (smp) { R[0][c] = __builtin_amdgcn_rcpf(a[0]); R[1][c] = __builtin_amdgcn_rcpf(a[1]); R[2][c] = __builtin_amdgcn_rcpf(a[2]); R[3][c] = __builtin_amdgcn_rcpf(a[3]); }
                    else { R[0][c] = a[1] * __builtin_amdgcn_rcpf(a[0]); R[1][c] = a[2] * __builtin_amdgcn_rcpf(a[1]); R[2][c] = a[3] * __builtin_amdgcn_rcpf(a[2]); R[3][c] = __builtin_amdgcn_rcpf(a[3]); } }
                bf16* gp = smp ? H + (size_t)(row0 + ai * HALF + m * 16) * HP + C_GL + nb : RB + rb0 + (ai * 8 + m * 2) * 512;
                const int sstr = smp ? DM : 65536;
#pragma unroll
                for (int p = 0; p < 2; ++p) {
                    unsigned ax = pk2(R[2 * p][0], R[2 * p][1]), ay = pk2(R[2 * p][2], R[2 * p][3]), bx = pk2(R[2 * p + 1][0], R[2 * p + 1][1]), by = pk2(R[2 * p + 1][2], R[2 * p + 1][3]);
                    { auto r = __builtin_amdgcn_permlane32_swap(ax, bx, false, false); ax = r[0]; bx = r[1]; }
                    { auto r = __builtin_amdgcn_permlane32_swap(ay, by, false, false); ay = r[0]; by = r[1]; }
                    if (smp) *(u32x4*)(gp + (2 * p + up) * sstr) = (u32x4){ax, ay, bx, by};
                    else __builtin_nontemporal_store((u32x4){ax, ay, bx, by}, (u32x4*)(gp + (2 * p + up) * sstr)); }
            }
    }
};
struct EpiOut {
    bf16* XN; float* XP; float* ssq;
    static __device__ __forceinline__ bool keep(const Unit&) { return false; }
    __device__ __forceinline__ void operator()(f32x4 (&acc)[2][2][4][2], const Unit& u, int wr, int wc, int fr, int fq) const {
        const int row0 = u.pm * BM + wr * 64 + fr, col0 = u.pn * BM + wc * 32 + 8 * fq;
        if (u.mode == 0) {
#pragma unroll
            for (int ai = 0; ai < 2; ++ai) {
                u32x4 x[4][2];
#pragma unroll
                for (int m = 0; m < 4; ++m)
#pragma unroll
                    for (int bj = 0; bj < 2; ++bj) x[m][bj] = *(const u32x4*)(XN + (size_t)(row0 + ai * HALF + m * 16) * DM + col0 + bj * HALF);
                asm volatile("" ::: "memory");
#pragma unroll
                for (int m = 0; m < 4; ++m) { float q = 0.f;
#pragma unroll
                    for (int bj = 0; bj < 2; ++bj) { const u32x4 xv = x[m][bj];
                        const f32x4 y0 = (f32x4){bflo(xv.x), bfhi(xv.x), bflo(xv.y), bfhi(xv.y)} + acc[ai][bj][m][0], y1 = (f32x4){bflo(xv.z), bfhi(xv.z), bflo(xv.w), bfhi(xv.w)} + acc[ai][bj][m][1];
                        q += ((y0[0] * y0[0] + y0[1] * y0[1]) + (y0[2] * y0[2] + y0[3] * y0[3])) + ((y1[0] * y1[0] + y1[1] * y1[1]) + (y1[2] * y1[2] + y1[3] * y1[3]));
                        u32x4 w; w.x = pk2(y0[0], y0[1]); w.y = pk2(y0[2], y0[3]); w.z = pk2(y1[0], y1[1]); w.w = pk2(y1[2], y1[3]);
                        *(u32x4*)(XN + (size_t)(row0 + ai * HALF + m * 16) * DM + col0 + bj * HALF) = w; }
                    if (ssq) { q += __shfl_xor(q, 16); q += __shfl_xor(q, 32);
                        if (fq == 0) ssq[(size_t)(row0 + ai * HALF + m * 16) * 32 + u.pn * 4 + wc] = q; } }
                asm volatile("" ::: "memory");
            }
        } else {
#pragma unroll
            for (int ai = 0; ai < 2; ++ai)
#pragma unroll
                for (int m = 0; m < 4; ++m) { float* rowp = XP + ((size_t)u.seg * MS + ((size_t)(row0 + ai * HALF + m * 16) - MP)) * DM + col0;
#pragma unroll
                    for (int bj = 0; bj < 2; ++bj) { f32x4* p = (f32x4*)(rowp + bj * HALF); p[0] = acc[ai][bj][m][0]; p[1] = acc[ai][bj][m][1]; } }
        }
    }
};
struct EpiMerge {
    const bf16* RB; bf16* H2;
    static __device__ __forceinline__ bool keep(const Unit& u) { return u.seg < 3; }
    __device__ __forceinline__ void operator()(f32x4 (&acc)[2][2][4][2], const Unit& u, int wr, int wc, int fr, int fq) const {
        const int row0 = u.pm * BM + wr * 64 + fr, col0 = u.pn * BM + wc * 32 + 8 * fq;
        const int seg = u.seg;
#pragma unroll
        for (int ai = 0; ai < 2; ++ai) {
            u32x4 g[4][2];
#pragma unroll
            for (int m = 0; m < 4; ++m)
#pragma unroll
                for (int bj = 0; bj < 2; ++bj) g[m][bj] = __builtin_nontemporal_load((const u32x4*)(RB + (size_t)(u.pm * 8 + u.pn) * 262144 + seg * 65536 + (wr * 4 + wc) * 8192 + (ai * 8 + m * 2 + bj) * 512 + (fq * 16 + fr) * 8));
            asm volatile("" ::: "memory");
#pragma unroll
            for (int m = 0; m < 4; ++m)
#pragma unroll
                for (int bj = 0; bj < 2; ++bj) { const u32x4 g0 = g[m][bj];
                    f32x4 a0 = acc[ai][bj][m][0], a1 = acc[ai][bj][m][1];
                    a0[0] *= bflo(g0.x); a0[1] *= bfhi(g0.x); a0[2] *= bflo(g0.y); a0[3] *= bfhi(g0.y); a1[0] *= bflo(g0.z); a1[1] *= bfhi(g0.z); a1[2] *= bflo(g0.w); a1[3] *= bfhi(g0.w);
                    acc[ai][bj][m][0] = a0; acc[ai][bj][m][1] = a1; }
        }
        if (seg == 3) {
#pragma unroll
            for (int ai = 0; ai < 2; ++ai)
#pragma unroll
                for (int m = 0; m < 4; ++m)
#pragma unroll
                    for (int bj = 0; bj < 2; ++bj) { const f32x4 a0 = acc[ai][bj][m][0], a1 = acc[ai][bj][m][1];
                        u32x4 w; w.x = pk2(a0[0], a0[1]); w.y = pk2(a0[2], a0[3]); w.z = pk2(a1[0], a1[1]); w.w = pk2(a1[2], a1[3]);
                        *(u32x4*)(H2 + (size_t)(row0 + ai * HALF + m * 16) * DM + col0 + bj * HALF) = w; }
        }
    }
};

struct EpiMergeS {
    const bf16* H; float* MP2;
    static __device__ __forceinline__ bool keep(const Unit&) { return false; }
    __device__ __forceinline__ void operator()(f32x4 (&acc)[2][2][4][2], const Unit& u, int wr, int wc, int fr, int fq) const {
        const int row0 = u.pm * BM + wr * 64 + fr, col0 = u.pn * BM + wc * 32 + 8 * fq;
        const int seg = u.seg;
        u32x4 g[2][4][2];
#pragma unroll
        for (int ai = 0; ai < 2; ++ai)
#pragma unroll
            for (int m = 0; m < 4; ++m)
#pragma unroll
                for (int bj = 0; bj < 2; ++bj) g[ai][m][bj] = *(const u32x4*)(H + (size_t)(row0 + ai * HALF + m * 16) * HP + C_GL + seg * DM + col0 + bj * HALF);
        asm volatile("" ::: "memory");
#pragma unroll
        for (int ai = 0; ai < 2; ++ai)
#pragma unroll
            for (int m = 0; m < 4; ++m) { const size_t row = (size_t)(row0 + ai * HALF + m * 16);
#pragma unroll
                for (int bj = 0; bj < 2; ++bj) { const u32x4 g0 = g[ai][m][bj];
                    const f32x4 a0 = acc[ai][bj][m][0], a1 = acc[ai][bj][m][1];
                    f32x4* p = (f32x4*)(MP2 + ((size_t)seg * MS + (row - MP)) * DM + col0 + bj * HALF);
                    p[0] = (f32x4){a0[0] * bflo(g0.x), a0[1] * bfhi(g0.x), a0[2] * bflo(g0.y), a0[3] * bfhi(g0.y)}; p[1] = (f32x4){a1[0] * bflo(g0.z), a1[1] * bfhi(g0.z), a1[2] * bflo(g0.w), a1[3] * bfhi(g0.w)}; } }
    }
};

template <class Epi, class Sched, bool ALIGN_EPI = false, bool SP2 = false, bool I8 = false>
__device__ __forceinline__ void gemm_phase(PG8_LAS unsigned char* lds, const Gemm g, const Sched& S, const Epi& E) {
    int tid_ = threadIdx.x; asm volatile("" : "+v"(tid_));
    const int tid = tid_, wid = __builtin_amdgcn_readfirstlane(tid >> 6), lane = tid & 63, wr = wid >> 2, wc = wid & 3, fr = lane & 15, fq = lane >> 4;
    const int K = g.K;
    unsigned voffA[2], voffB[2];
#pragma unroll
    for (int i = 0; i < 2; ++i) { int R, C; stage_rc(tid * 16 + i * 8192, R, C); const int Rb = (R & ~31) + perm32(R & 31);
        voffA[i] = (unsigned)(R * K + C * 2); voffB[i] = (unsigned)(Rb * K + C * 2); }
    const size_t kstep = (size_t)(BK * 2);
    const size_t hstep = (size_t)HALF * K;
    const size_t tstep = 2 * hstep;
    const unsigned ldsw = (unsigned)wid * 1024u;
    const int aoff = lds_byte(wr * 64 + fr, fq * 8), boff = lds_byte(wc * 32 + fr, fq * 8);
#define PG8_SA(b, h) (((b) * 2 + (h)) * HTB)
#define PG8_SB(b, h) ((4 + (b) * 2 + (h)) * HTB)
#define PG8_STAGE(bufoff, gbase, voff) do { _Pragma("unroll") for (int _i = 0; _i < 2; ++_i) \
        __builtin_amdgcn_global_load_lds((const unsigned*)((const char*)(gbase) + (voff)[_i]), (PG8_LAS unsigned*)(lds + (bufoff) + ldsw + _i * 8192), 16, 0, 0); } while (0)
#define PG8_LDA(dst, b, h) do { _Pragma("unroll") for (int m = 0; m < 4; ++m) _Pragma("unroll") for (int k = 0; k < 2; ++k) dst[m][k] = *(const PG8_LAS bf16x8*)(lds + PG8_SA(b, h) + aoff + m * 2048 + k * 1024); } while (0)
#define PG8_LDB(dst, b, h) do { _Pragma("unroll") for (int n = 0; n < 2; ++n) _Pragma("unroll") for (int k = 0; k < 2; ++k) dst[n][k] = *(const PG8_LAS bf16x8*)(lds + PG8_SB(b, h) + boff + n * 2048 + k * 1024); } while (0)
#define PG8_MMA(ai, bj, At, Bt) do { __builtin_amdgcn_s_setprio(1); _Pragma("unroll") for (int m = 0; m < 4; ++m) _Pragma("unroll") for (int n = 0; n < 2; ++n) _Pragma("unroll") for (int k = 0; k < 2; ++k) \
        { if constexpr (I8) acc[ai][bj][m][n] = __builtin_bit_cast(acc4, __builtin_amdgcn_mfma_i32_16x16x64_i8(__builtin_bit_cast(i32x4, Bt[n][k]), __builtin_bit_cast(i32x4, At[m][k]), __builtin_bit_cast(i32x4, acc[ai][bj][m][n]), 0, 0, 0)); \
          else acc[ai][bj][m][n] = __builtin_bit_cast(acc4, __builtin_amdgcn_mfma_f32_16x16x32_bf16(Bt[n][k], At[m][k], __builtin_bit_cast(f32x4, acc[ai][bj][m][n]), 0, 0, 0)); } __builtin_amdgcn_s_setprio(0); } while (0)
#define PG8_WAIT_V(n) asm volatile("s_waitcnt vmcnt(" #n ")" ::: "memory")
#define PG8_WAIT_L(n) asm volatile("s_waitcnt lgkmcnt(" #n ")" ::: "memory")
#define PG8_BAR __builtin_amdgcn_s_barrier()
#define PG8_SCHED __builtin_amdgcn_sched_barrier(0)
    Unit cur, nxt; int ui = 0;
    if (!S.next(0, cur)) return;
    typedef typename std::conditional<I8, i32x4, f32x4>::type acc4;
    acc4 acc[2][2][4][2];
#pragma unroll
    for (int a = 0; a < 2; ++a)
#pragma unroll
        for (int b = 0; b < 2; ++b)
#pragma unroll
            for (int m = 0; m < 4; ++m)
#pragma unroll
                for (int n = 0; n < 2; ++n) acc[a][b][m][n] = (acc4){0, 0, 0, 0};
    bf16x8 At[4][2], B0[2][2], B1[2][2];
    const char* cA = (const char*)g.A + (size_t)cur.pm * tstep + (size_t)cur.seg * g.segb; const char* cB = (const char*)g.Bt + (size_t)cur.pn * tstep + (size_t)cur.seg * g.segb;
    if constexpr (SP2) {
        PG8_STAGE(PG8_SB(0, 0), cB, voffB); PG8_STAGE(PG8_SB(0, 1), cB + hstep, voffB); PG8_STAGE(PG8_SA(0, 0), cA, voffA); PG8_STAGE(PG8_SA(0, 1), cA + hstep, voffA);
        if (wr == 1) PG8_BAR;
        PG8_WAIT_V(2); PG8_BAR;
        PG8_STAGE(PG8_SB(1, 0), cB + kstep, voffB); PG8_STAGE(PG8_SA(1, 0), cA + kstep, voffA); PG8_STAGE(PG8_SB(1, 1), cB + hstep + kstep, voffB);
        PG8_WAIT_V(6); PG8_BAR;
    } else {
        PG8_STAGE(PG8_SB(0, 0), cB, voffB); PG8_STAGE(PG8_SA(0, 0), cA, voffA); PG8_STAGE(PG8_SB(0, 1), cB + hstep, voffB); PG8_STAGE(PG8_SA(0, 1), cA + hstep, voffA);
        if (wr == 1) PG8_BAR;
        PG8_WAIT_V(4); PG8_BAR;
        PG8_STAGE(PG8_SB(1, 0), cB + kstep, voffB); PG8_STAGE(PG8_SA(1, 0), cA + kstep, voffA); PG8_STAGE(PG8_SB(1, 1), cB + hstep + kstep, voffB);
        PG8_WAIT_V(6); PG8_BAR;
    }
    for (;;) {
        const bool has_next = S.next(ui + 1, nxt);
        const char* nA = has_next ? (const char*)g.A + (size_t)nxt.pm * tstep + (size_t)nxt.seg * g.segb : cA;
        const char* nB = has_next ? (const char*)g.Bt + (size_t)nxt.pn * tstep + (size_t)nxt.seg * g.segb : cB;
        const int nt = cur.nt;
        for (int t = 0; t < nt; t += 2) {
            const bool last = (t == nt - 2);
            const char* a1 = cA + (size_t)(t + 1) * kstep;
            const char* a2 = last ? nA : cA + (size_t)(t + 2) * kstep; const char* b2 = last ? nB : cB + (size_t)(t + 2) * kstep;
            const char* a3 = a2 + kstep; const char* b3 = b2 + kstep;
            if constexpr (SP2) {
            PG8_LDB(B0, 0, 0); PG8_LDB(B1, 0, 1); PG8_SCHED; PG8_LDA(At, 0, 0); PG8_STAGE(PG8_SA(1, 1), a1 + hstep, voffA);
            PG8_WAIT_V(8); PG8_WAIT_L(0); PG8_BAR; PG8_MMA(0, 0, At, B0); PG8_MMA(0, 1, At, B1); PG8_BAR; PG8_SCHED;
            PG8_LDA(At, 0, 1); PG8_STAGE(PG8_SB(0, 0), b2, voffB); PG8_STAGE(PG8_SB(0, 1), b2 + hstep, voffB); PG8_STAGE(PG8_SA(0, 0), a2, voffA);
            PG8_WAIT_V(8); PG8_WAIT_L(0); PG8_BAR; PG8_MMA(1, 0, At, B0); PG8_MMA(1, 1, At, B1); PG8_BAR; PG8_SCHED;
            PG8_LDB(B0, 1, 0); PG8_LDB(B1, 1, 1); PG8_SCHED; PG8_LDA(At, 1, 0); PG8_STAGE(PG8_SA(0, 1), a2 + hstep, voffA);
            PG8_WAIT_V(8); PG8_WAIT_L(0); PG8_BAR; PG8_MMA(0, 0, At, B0); PG8_MMA(0, 1, At, B1); PG8_BAR; PG8_SCHED;
            PG8_LDA(At, 1, 1); PG8_STAGE(PG8_SB(1, 0), b3, voffB); PG8_STAGE(PG8_SB(1, 1), b3 + hstep, voffB); PG8_STAGE(PG8_SA(1, 0), a3, voffA);
            PG8_WAIT_V(8); PG8_WAIT_L(0); PG8_BAR; PG8_MMA(1, 0, At, B0); PG8_MMA(1, 1, At, B1); PG8_BAR; PG8_SCHED;
            } else {
            PG8_LDB(B0, 0, 0); PG8_SCHED; PG8_LDA(At, 0, 0); PG8_STAGE(PG8_SA(1, 1), a1 + hstep, voffA);
            PG8_WAIT_L(8); PG8_BAR; PG8_WAIT_L(0); PG8_MMA(0, 0, At, B0); PG8_BAR; PG8_SCHED;
            PG8_LDB(B1, 0, 1); PG8_STAGE(PG8_SB(0, 0), b2, voffB);
            PG8_BAR; PG8_WAIT_L(0); PG8_MMA(0, 1, At, B1); PG8_BAR;
            PG8_LDA(At, 0, 1); PG8_STAGE(PG8_SA(0, 0), a2, voffA);
            PG8_BAR; PG8_WAIT_L(0); PG8_MMA(1, 0, At, B0); PG8_BAR; PG8_SCHED;
            PG8_STAGE(PG8_SB(0, 1), b2 + hstep, voffB);
            PG8_WAIT_V(6); PG8_BAR; PG8_MMA(1, 1, At, B1); PG8_BAR;
            PG8_LDB(B0, 1, 0); PG8_SCHED; PG8_LDA(At, 1, 0); PG8_STAGE(PG8_SA(0, 1), a2 + hstep, voffA);
            PG8_WAIT_L(8); PG8_BAR; PG8_WAIT_L(0); PG8_MMA(0, 0, At, B0); PG8_BAR; PG8_SCHED;
            PG8_LDB(B1, 1, 1); PG8_STAGE(PG8_SB(1, 0), b3, voffB);
            PG8_BAR; PG8_WAIT_L(0); PG8_MMA(0, 1, At, B1); PG8_BAR;
            PG8_LDA(At, 1, 1); PG8_STAGE(PG8_SA(1, 0), a3, voffA);
            PG8_BAR; PG8_WAIT_L(0); PG8_MMA(1, 0, At, B0); PG8_BAR; PG8_SCHED;
            PG8_STAGE(PG8_SB(1, 1), b3 + hstep, voffB);
            PG8_WAIT_V(6); PG8_BAR; PG8_MMA(1, 1, At, B1); PG8_BAR;
            }
        }
        if constexpr (ALIGN_EPI) { if (wr == 0) PG8_BAR; }
        { Unit eu = cur; { int a_ = cur.pm, b_ = cur.pn, c_ = cur.seg; asm volatile("" : "+v"(a_), "+v"(b_), "+v"(c_)); eu.pm = __builtin_amdgcn_readfirstlane(a_); eu.pn = __builtin_amdgcn_readfirstlane(b_); eu.seg = __builtin_amdgcn_readfirstlane(c_); }
          E(acc, eu, wr, wc, fr, fq); }
        if (!has_next) break;
        if (!Epi::keep(cur)) {
#pragma unroll
        for (int a = 0; a < 2; ++a)
#pragma unroll
            for (int b = 0; b < 2; ++b)
#pragma unroll
                for (int m = 0; m < 4; ++m)
#pragma unroll
                    for (int n = 0; n < 2; ++n) acc[a][b][m][n] = (acc4){0, 0, 0, 0};
        }
        cur = nxt; cA = nA; cB = nB; ++ui;
        if constexpr (ALIGN_EPI) { if (wr == 1) PG8_BAR; }
    }
    PG8_WAIT_V(0);
    if constexpr (!ALIGN_EPI) { if (wr == 0) PG8_BAR; }
    PG8_BAR;
#undef PG8_SA
#undef PG8_SB
#undef PG8_STAGE
#undef PG8_LDA
#undef PG8_LDB
#undef PG8_MMA
#undef PG8_WAIT_V
#undef PG8_WAIT_L
#undef PG8_BAR
#undef PG8_SCHED
}
}

#define XB_TMO      128
#define XB_XCNT(j)  (256  + 64 * (j))
#define XB_XSUB(j)  (1280 + 64 * (j))
#define XB_XGEN(j)  (2304 + 64 * (j))
#define XB_TOP      3328
#define XB_TOPGEN   3392
#define XCD_BAR_WORDS 3456
#define XB_SPIN_CAP (1u << 18)
__device__ __forceinline__ unsigned xb_ld(unsigned* p)              { return __hip_atomic_load(p, __ATOMIC_RELAXED, __HIP_MEMORY_SCOPE_AGENT); }
__device__ __forceinline__ unsigned xb_add(unsigned* p, unsigned v) { return __hip_atomic_fetch_add(p, v, __ATOMIC_RELAXED, __HIP_MEMORY_SCOPE_AGENT); }
__device__ __forceinline__ unsigned xb_xcc_id() { return (unsigned)__builtin_amdgcn_s_getreg((3 << 11) | 20) & 0xFu; }
#define XB_SPIN(cond, bar) do { unsigned _sp = 0; while (cond) { __builtin_amdgcn_s_sleep(1); \
    if ((++_sp & 255u) == 0u) { if (xb_ld(&(bar)[XB_TMO])) break; if (_sp > XB_SPIN_CAP) { atomicAdd(&(bar)[XB_TMO], 1u); break; } } } } while (0)
struct XcdBarrier { unsigned* bar; unsigned x; volatile LAS unsigned* st; };
__device__ __forceinline__ XcdBarrier xcd_barrier_post(unsigned* bar, volatile LAS unsigned* st) {
    XcdBarrier b; b.bar = bar; b.x = xb_xcc_id(); b.st = st;
    if (threadIdx.x == 0) (void)xb_add(&bar[XB_XCNT(b.x)], 1u);
    return b;
}
__device__ __forceinline__ void xcd_barrier_complete(unsigned* bar, unsigned x, unsigned& nloc, unsigned& nx) {
    const unsigned G = gridDim.x * gridDim.y * gridDim.z;
    unsigned sum, cnt, mine, sp = 0u;
    for (;;) {
        sum = 0u; cnt = 0u; mine = 0u;
#pragma unroll
        for (unsigned j = 0; j < 16; ++j) { const unsigned c = xb_ld(&bar[XB_XCNT(j)]); sum += c; cnt += (c > 0u) ? 1u : 0u; mine = (j == x) ? c : mine; }
        if (sum == G) break;
        __builtin_amdgcn_s_sleep(1);
        if ((++sp & 255u) == 0u) { if (xb_ld(&bar[XB_TMO])) break; if (sp > XB_SPIN_CAP) { atomicAdd(&bar[XB_TMO], 1u); break; } }
    }
    nloc = mine > 0u ? mine : 1u; nx = cnt > 0u ? cnt : 1u;
}
__device__ __forceinline__ void xcd_barrier(const XcdBarrier& b) {
    asm volatile("s_waitcnt vmcnt(0)" ::: "memory");
    __syncthreads();
    if (threadIdx.x == 0) {
        unsigned* bar = b.bar;
        __builtin_amdgcn_s_waitcnt(0);
        unsigned nloc = b.st[0], nx = b.st[1];
        if (nloc == 0u) { xcd_barrier_complete(bar, b.x, nloc, nx); b.st[0] = nloc; b.st[1] = nx; }
        const unsigned old = xb_add(&bar[XB_XSUB(b.x)], 1u);
        const unsigned gen = old / nloc;
        if (old + 1u == (gen + 1u) * nloc) {
            __builtin_amdgcn_fence(__ATOMIC_RELEASE, "agent");
            asm volatile("s_waitcnt vmcnt(0)" ::: "memory");
            const unsigned og = xb_add(&bar[XB_TOP], 1u);
            const unsigned tg = og / nx;
            if (og + 1u == (tg + 1u) * nx) xb_add(&bar[XB_TOPGEN], 1u);
            else XB_SPIN(xb_ld(&bar[XB_TOPGEN]) == tg, bar);
            __builtin_amdgcn_fence(__ATOMIC_ACQUIRE, "agent");
            xb_add(&bar[XB_XGEN(b.x)], 1u);
            asm volatile("s_waitcnt vmcnt(0)" ::: "memory");
        } else {
            XB_SPIN(xb_ld(&bar[XB_XGEN(b.x)]) == gen, bar);
            __builtin_amdgcn_fence(__ATOMIC_ACQUIRE, "agent");
            asm volatile("s_waitcnt vmcnt(0)" ::: "memory");
        }
    }
    __syncthreads();
}

template <bool GAIN> __device__ __forceinline__ void transpose_item(const float* W, int ldw, int k0, int n0, bf16* WT, int ldt, int kofs, LAS float* scr, int lane, const float* kgain = nullptr, int ndst = -1) {
    if (ndst < 0) ndst = n0;
    float wv[32];
#pragma unroll
    for (int i = 0; i < 32; ++i) { const int kk = 2 * i + (lane >> 5); wv[i] = __builtin_nontemporal_load(W + (size_t)(k0 + kk) * ldw + n0 + (lane & 31)); }
#pragma unroll
    for (int i = 0; i < 32; ++i) { const int kk = 2 * i + (lane >> 5); scr[kk * 33 + (lane & 31)] = GAIN ? wv[i] * kgain[k0 + kk] : wv[i]; }
    asm volatile("s_waitcnt lgkmcnt(0)" ::: "memory");
    const int c = lane & 7;
#pragma unroll
    for (int j = 0; j < 4; ++j) { const int n = (lane >> 3) + 8 * j; const LAS float* s = scr + (8 * c) * 33 + n;
        u32x4 o; o.x = pk2(s[0 * 33], s[1 * 33]); o.y = pk2(s[2 * 33], s[3 * 33]); o.z = pk2(s[4 * 33], s[5 * 33]); o.w = pk2(s[6 * 33], s[7 * 33]);
        const int nr = ndst + n;
        *(u32x4*)(WT + (size_t)nr * ldt + kofs + k0 + 8 * c) = o; }
    asm volatile("s_waitcnt lgkmcnt(0)" ::: "memory");
}
__device__ __forceinline__ unsigned pack_i8x4(float a, float b, float c, float d) {
    const int ia = (int)rintf(a), ib = (int)rintf(b), ic = (int)rintf(c), id = (int)rintf(d);
    return (unsigned)(ia & 255) | ((unsigned)(ib & 255) << 8) | ((unsigned)(ic & 255) << 16) | ((unsigned)id << 24);
}
__device__ __forceinline__ void colmax_item(const float* W, int ldw, int k0, int n0, const float* kgain, unsigned* cmax, int lane) {
    float m = 0.f;
#pragma unroll 8
    for (int i = 0; i < 32; ++i) { const int kk = 2 * i + (lane >> 5); m = fmaxf(m, fabsf(W[(size_t)(k0 + kk) * ldw + n0 + (lane & 31)] * kgain[k0 + kk])); }
    m = fmaxf(m, __shfl_xor(m, 32));
    if (lane < 32) __hip_atomic_fetch_max(cmax + lane, __builtin_bit_cast(unsigned, m), __ATOMIC_RELAXED, __HIP_MEMORY_SCOPE_AGENT);
}
__device__ __forceinline__ void transq_item(const float* W, int ldw, int k0, int n0, signed char* WQ, float* SW, const unsigned* cmax, const float* kgain, LAS float* scr, int lane, bool gate, int base) {
#pragma unroll 8
    for (int i = 0; i < 32; ++i) { const int kk = 2 * i + (lane >> 5); scr[kk * 33 + (lane & 31)] = W[(size_t)(k0 + kk) * ldw + n0 + (lane & 31)] * kgain[k0 + kk]; }
    asm volatile("s_waitcnt lgkmcnt(0)" ::: "memory");
    const int c = lane & 7;
#pragma unroll
    for (int j = 0; j < 4; ++j) { const int n = (lane >> 3) + 8 * j; const LAS float* sp = scr + (8 * c) * 33 + n;
        const int gc = base + n, i = gc >> 11, ch = gc & 2047, r = ch & 63;
        const int pos = gate ? NQM + (ch >> 6) * 256 + ((r >> 1) & 1) * 128 + (r >> 4) * 32 + (((r >> 3) & 1) + 2 * ((r >> 2) & 1)) * 8 + (r & 1) * 4 + i : base + n;
        const float cm = __builtin_bit_cast(float, cmax[gate ? NQM + gc : base + n]), inv = cm > 0.f ? 127.f / cm : 0.f;
        u32x2 o; o.x = pack_i8x4(sp[0 * 33] * inv, sp[1 * 33] * inv, sp[2 * 33] * inv, sp[3 * 33] * inv); o.y = pack_i8x4(sp[4 * 33] * inv, sp[5 * 33] * inv, sp[6 * 33] * inv, sp[7 * 33] * inv);
        *(u32x2*)(WQ + (size_t)pos * DM + k0 + 8 * c) = o;
        if (k0 == 0 && c == 0) SW[pos] = cm * (1.f / 127.f); }
    asm volatile("s_waitcnt lgkmcnt(0)" ::: "memory");
}
__device__ __forceinline__ void quantw_item(const float* W, int n0, const float* kgain, signed char* WQ, float* SW, bool gate, int base, LAS float* red, int tid) {
    const int lane = tid & 63, wave = tid >> 6, n = lane & 31, kb = wave * 256 + (lane >> 5) * 128;
    const unsigned off = (unsigned)(kb * HP + n0 + n);
    typedef __fp16 hf2 __attribute__((ext_vector_type(2)));
    unsigned pk[64]; float m = 0.f;
#pragma unroll
    for (int c = 0; c < 4; ++c) {
        float v[32];
#pragma unroll
        for (int i = 0; i < 32; ++i) v[i] = __builtin_nontemporal_load(W + (off + (unsigned)((32 * c + i) * HP)));
#pragma unroll
        for (int i = 0; i < 32; i += 4) { const f32x4 g = *(const f32x4*)(kgain + kb + 32 * c + i);
            v[i] *= g.x; v[i + 1] *= g.y; v[i + 2] *= g.z; v[i + 3] *= g.w;
            m = fmaxf(fmaxf(m, fmaxf(fabsf(v[i]), fabsf(v[i + 1]))), fmaxf(fabsf(v[i + 2]), fabsf(v[i + 3])));
            pk[16 * c + (i >> 1)] = __builtin_bit_cast(unsigned, __builtin_amdgcn_cvt_pkrtz(v[i], v[i + 1]));
            pk[16 * c + (i >> 1) + 1] = __builtin_bit_cast(unsigned, __builtin_amdgcn_cvt_pkrtz(v[i + 2], v[i + 3])); }
    }
    m = fmaxf(m, __shfl_xor(m, 32));
    if (lane < 32) red[wave * 32 + lane] = m;
    __syncthreads();
    float cm = red[n];
#pragma unroll
    for (int w = 1; w < 8; ++w) cm = fmaxf(cm, red[w * 32 + n]);
    const float inv = cm > 0.f ? 127.f / cm : 0.f;
    const int gc = base + n, gi = gc >> 11, ch = gc & 2047, r = ch & 63;
    const int pos = gate ? NQM + (ch >> 6) * 256 + ((r >> 1) & 1) * 128 + (r >> 4) * 32 + (((r >> 3) & 1) + 2 * ((r >> 2) & 1)) * 8 + (r & 1) * 4 + gi : base + n;
    signed char* dst = WQ + (size_t)pos * DM + kb;
#pragma unroll
    for (int q = 0; q < 8; ++q) { u32x4 o;
#pragma unroll
        for (int e = 0; e < 4; ++e) { const hf2 h0 = __builtin_bit_cast(hf2, pk[8 * q + 2 * e]), h1 = __builtin_bit_cast(hf2, pk[8 * q + 2 * e + 1]);
            o[e] = pack_i8x4((float)h0[0] * inv, (float)h0[1] * inv, (float)h1[0] * inv, (float)h1[1] * inv); }
        __builtin_nontemporal_store(o, (u32x4*)(dst + 16 * q)); }
    if (tid < 32) SW[pos] = cm * (1.f / 127.f);
    __syncthreads();
}
__device__ __forceinline__ void norm_row(const float* src, float* xcopy, bf16* xn, float* yout, const float* gain, int lane, const float* part = nullptr, float* ssq_out = nullptr, signed char* xq = nullptr, float* rsc_out = nullptr) {
    const f32x4* xr = (const f32x4*)src + lane;
    f32x4 v[8]; float s = 0.f;
#pragma unroll
    for (int j = 0; j < 8; ++j) v[j] = __builtin_nontemporal_load(xr + 64 * j);
    if (part) {
#pragma unroll
        for (int q = 0; q < 8; ++q) { const f32x4* pr = (const f32x4*)(part + (size_t)q * MS * DM) + lane;
#pragma unroll
            for (int j = 0; j < 8; ++j) v[j] += pr[64 * j]; }
    }
#pragma unroll
    for (int j = 0; j < 8; ++j) s += (v[j].x * v[j].x + v[j].y * v[j].y) + (v[j].z * v[j].z + v[j].w * v[j].w);
    const float tot = wave_sum(s);
    const float rstd = ssq_out ? 1.f : __builtin_amdgcn_rsqf(tot * (1.f / DM) + NORM_EPS);
    if (ssq_out && lane == 0) *ssq_out = tot;
    if (xq) {
        float am = 0.f;
#pragma unroll
        for (int j = 0; j < 8; ++j) am = fmaxf(fmaxf(am, fmaxf(fabsf(v[j].x), fabsf(v[j].y))), fmaxf(fabsf(v[j].z), fabsf(v[j].w)));
        am = wave_max(am);
        const float inv = am > 0.f ? 127.f / am : 0.f;
        if (lane == 0) *rsc_out = __builtin_amdgcn_rsqf(tot * (1.f / DM) + NORM_EPS) * am * (1.f / 127.f);
#pragma unroll
        for (int j = 0; j < 8; ++j) ((unsigned*)xq + lane)[64 * j] = pack_i8x4(v[j].x * inv, v[j].y * inv, v[j].z * inv, v[j].w * inv);
    }
    if (xcopy) {
#pragma unroll
        for (int j = 0; j < 8; ++j) ((f32x4*)xcopy + lane)[64 * j] = v[j];
    }
    const f32x4* gr = (const f32x4*)gain + lane;
#pragma unroll
    for (int j = 0; j < 8; ++j) { const f32x4 y = ssq_out ? v[j] : v[j] * rstd * gr[64 * j];
        if (xn) { u32x2 w; w.x = pk2(y.x, y.y); w.y = pk2(y.z, y.w); ((u32x2*)xn + lane)[64 * j] = w; }
        else ((f32x4*)yout + lane)[64 * j] = y; }
}

__device__ __forceinline__ void norm_row_bf(const bf16* src, bf16* xn, float* yout, const float* gain, int lane, const float* part, float* ssq_out, signed char* xq = nullptr, float* rsc_out = nullptr) {
    f32x4 v[4][2]; float s = 0.f;
#pragma unroll
    for (int j = 0; j < 4; ++j) { const u32x4 t = *(const u32x4*)(src + lane * 8 + 512 * j);
        v[j][0] = (f32x4){bflo(t.x), bfhi(t.x), bflo(t.y), bfhi(t.y)}; v[j][1] = (f32x4){bflo(t.z), bfhi(t.z), bflo(t.w), bfhi(t.w)}; }
    if (part) {
#pragma unroll
        for (int qh = 0; qh < 2; ++qh) { f32x4 pv[4][4][2];
#pragma unroll
            for (int q = 0; q < 4; ++q) { const float* pr = part + (size_t)(qh * 4 + q) * MS * DM + lane * 8;
#pragma unroll
                for (int j = 0; j < 4; ++j) { pv[q][j][0] = *(const f32x4*)(pr + 512 * j); pv[q][j][1] = *(const f32x4*)(pr + 512 * j + 4); } }
            asm volatile("" ::: "memory");
#pragma unroll
            for (int q = 0; q < 4; ++q)
#pragma unroll
                for (int j = 0; j < 4; ++j) { v[j][0] += pv[q][j][0]; v[j][1] += pv[q][j][1]; }
            asm volatile("" ::: "memory"); }
    }
#pragma unroll
    for (int j = 0; j < 4; ++j)
#pragma unroll
        for (int hf = 0; hf < 2; ++hf) { const f32x4 a = v[j][hf]; s += (a.x * a.x + a.y * a.y) + (a.z * a.z + a.w * a.w); }
    const float tot = wave_sum(s);
    if (ssq_out) {
        if (lane == 0) *ssq_out = tot;
        if (xq) {
            float am = 0.f;
#pragma unroll
            for (int j = 0; j < 4; ++j)
#pragma unroll
                for (int hf = 0; hf < 2; ++hf) { const f32x4 a = v[j][hf]; am = fmaxf(fmaxf(am, fmaxf(fabsf(a.x), fabsf(a.y))), fmaxf(fabsf(a.z), fabsf(a.w))); }
            am = wave_max(am);
            const float inv = am > 0.f ? 127.f / am : 0.f;
            if (lane == 0) *rsc_out = __builtin_amdgcn_rsqf(tot * (1.f / DM) + NORM_EPS) * am * (1.f / 127.f);
#pragma unroll
            for (int j = 0; j < 4; ++j) *(u32x2*)(xq + lane * 8 + 512 * j) = (u32x2){pack_i8x4(v[j][0].x * inv, v[j][0].y * inv, v[j][0].z * inv, v[j][0].w * inv), pack_i8x4(v[j][1].x * inv, v[j][1].y * inv, v[j][1].z * inv, v[j][1].w * inv)};
        }
        if (xn) {
#pragma unroll
        for (int j = 0; j < 4; ++j) { u32x4 w; w.x = pk2(v[j][0].x, v[j][0].y); w.y = pk2(v[j][0].z, v[j][0].w); w.z = pk2(v[j][1].x, v[j][1].y); w.w = pk2(v[j][1].z, v[j][1].w);
            *(u32x4*)(xn + lane * 8 + 512 * j) = w; } }
    } else {
        const float rstd = __builtin_amdgcn_rsqf(tot * (1.f / DM) + NORM_EPS);
#pragma unroll
        for (int j = 0; j < 4; ++j) { const float* gp = gain + lane * 8 + 512 * j; v[j][0] = v[j][0] * rstd * *(const f32x4*)gp; v[j][1] = v[j][1] * rstd * *(const f32x4*)(gp + 4); }
        asm volatile("" ::: "memory");
#pragma unroll
        for (int j = 0; j < 4; ++j) { float* op = yout + lane * 8 + 512 * j; *(f32x4*)op = v[j][0]; *(f32x4*)(op + 4) = v[j][1]; }
    }
}

struct MixArgs {
    const bf16* H; bf16* BR; float* out; float* U; bf16* SB;
    const float *state_ret, *state_conv, *cache_k, *cache_v, *conv_w, *ln_g, *ln_b, *gws, *gbs, *relb;
    int l;
};

__device__ __forceinline__ void attn_prompt_unit(const MixArgs& A, int unit, LAS uchar* lds, int tid, int lane, int wave) {
    const int qg = unit & 7, h = (unit >> 3) & 7, b = unit >> 6;
    LAS float* tb = (LAS float*)(lds + 36864);
    const bf16* H = A.H;
    __syncthreads();
    for (int i = tid; i < 257; i += NTHR) tb[i] = A.relb[h * 257 + i] * LOG2E;
    const int c = 4 * qg + (wave >> 1);
    const int qi = (wave & 1) * 32 + (lane & 31), hh = lane >> 5;
    const size_t qrow = (size_t)b * SEQ + c * 64 + qi;
    bf16x8 qf[4];
#pragma unroll
    for (int ks = 0; ks < 4; ++ks) { u32x4 t = *(const u32x4*)(H + qrow * HP + C_AQ + h * 64 + ks * 16 + 8 * hh);
        const float c2 = 0.125f * LOG2E;
        t.x = pk2(bflo(t.x) * c2, bfhi(t.x) * c2); t.y = pk2(bflo(t.y) * c2, bfhi(t.y) * c2); t.z = pk2(bflo(t.z) * c2, bfhi(t.z) * c2); t.w = pk2(bflo(t.w) * c2, bfhi(t.w) * c2);
        qf[ks] = __builtin_bit_cast(bf16x8, t); }
    f32x16 o0 = {}, o1 = {};
    float mrun = -1e30f, lsum = 0.f;
    const int kt_lo = (4 * qg - 8) > 0 ? (4 * qg - 8) : 0, kt_hi = 4 * qg + 3;
    const int skey = tid >> 3, spart = tid & 7;
    u32x4 kreg, vreg, kreg2 = {0u, 0u, 0u, 0u}, vreg2 = {0u, 0u, 0u, 0u};
    { const size_t r0 = (size_t)b * SEQ + kt_lo * 64;
      kreg = *(const u32x4*)(H + (r0 + skey) * HP + C_AK + h * 64 + spart * 8);
      vreg = *(const u32x4*)(H + (r0 + skey) * HP + C_AV + h * 64 + spart * 8);
      if (kt_lo < kt_hi) { kreg2 = *(const u32x4*)(H + (r0 + 64 + skey) * HP + C_AK + h * 64 + spart * 8); vreg2 = *(const u32x4*)(H + (r0 + 64 + skey) * HP + C_AV + h * 64 + spart * 8); } }
#define ATT_STAGE(bufp) do { LAS uchar* Ks_ = (bufp); LAS uchar* Vt_ = (bufp) + 9216; \
        *(LAS u32x4*)(Ks_ + skey * 144 + spart * 16) = kreg; \
        LAS uchar* vp = Vt_ + (spart * 8) * 144 + (skey ^ (spart << 3)) * 2;          \
        *(LAS bf16*)(vp + 0 * 144) = (bf16)(vreg.x & 0xffffu); *(LAS bf16*)(vp + 1 * 144) = (bf16)(vreg.x >> 16); \
        *(LAS bf16*)(vp + 2 * 144) = (bf16)(vreg.y & 0xffffu); *(LAS bf16*)(vp + 3 * 144) = (bf16)(vreg.y >> 16); \
        *(LAS bf16*)(vp + 4 * 144) = (bf16)(vreg.z & 0xffffu); *(LAS bf16*)(vp + 5 * 144) = (bf16)(vreg.z >> 16); \
        *(LAS bf16*)(vp + 6 * 144) = (bf16)(vreg.w & 0xffffu); *(LAS bf16*)(vp + 7 * 144) = (bf16)(vreg.w >> 16); } while (0)
    ATT_STAGE(lds);
    kreg = kreg2; vreg = vreg2;
    if (kt_lo + 2 <= kt_hi) { const size_t r0 = (size_t)b * SEQ + (kt_lo + 2) * 64;
        kreg2 = *(const u32x4*)(H + (r0 + skey) * HP + C_AK + h * 64 + spart * 8);
        vreg2 = *(const u32x4*)(H + (r0 + skey) * HP + C_AV + h * 64 + spart * 8); }
    __syncthreads();
    for (int kt = kt_lo; kt <= kt_hi; ++kt) {
        LAS uchar* Ks = lds + ((kt - kt_lo) & 1) * 18432; LAS uchar* Vt = Ks + 9216;
        if (kt < kt_hi) {
            ATT_STAGE(lds + ((kt + 1 - kt_lo) & 1) * 18432);
            kreg = kreg2; vreg = vreg2;
            if (kt + 3 <= kt_hi) { const size_t r0 = (size_t)b * SEQ + (kt + 3) * 64;
                kreg2 = *(const u32x4*)(H + (r0 + skey) * HP + C_AK + h * 64 + spart * 8);
                vreg2 = *(const u32x4*)(H + (r0 + skey) * HP + C_AV + h * 64 + spart * 8); } }
        if (kt >= c - 8 && kt <= c) {
            f32x16 s0 = {}, s1 = {};
#pragma unroll
            for (int ks = 0; ks < 4; ++ks) {
                const bf16x8 a0 = ldfrag(Ks, 144, 0, ks * 16, lane), a1 = ldfrag(Ks, 144, 32, ks * 16, lane);
                s0 = MFMA32(a0, qf[ks], s0); s1 = MFMA32(a1, qf[ks], s1);
            }
            const int dc = c - kt;
            float bb = 0.f;
            if (dc >= 3) bb = tb[256];
            else {
                const int base = dc * 64 + qi - 4 * hh + 128;
#pragma unroll
                for (int r = 0; r < 16; ++r) { const int ki = (r & 3) + 8 * (r >> 2);
                    int i0 = base - ki, i1 = base - ki - 32;
                    i0 = i0 < 0 ? 0 : (i0 > 256 ? 256 : i0); i1 = i1 < 0 ? 0 : (i1 > 256 ? 256 : i1);
                    s0[r] += tb[i0]; s1[r] += tb[i1]; }
            }
            float mt = s0[0];
#pragma unroll
            for (int r = 1; r < 16; ++r) mt = fmaxf(mt, s0[r]);
#pragma unroll
            for (int r = 0; r < 16; ++r) mt = fmaxf(mt, s1[r]);
            mt = fmaxf(mt, __shfl_xor(mt, 32)) + bb;
            const float mnew = fmaxf(mrun, mt), alpha = ex2(mrun - mnew), moff = mnew - bb;
            float ps = 0.f;
#pragma unroll
            for (int r = 0; r < 16; ++r) { s0[r] = ex2(s0[r] - moff); s1[r] = ex2(s1[r] - moff); ps += s0[r] + s1[r]; }
            lsum = lsum * alpha + ps; mrun = mnew;
            if (__any(alpha != 1.f)) {
#pragma unroll
                for (int r = 0; r < 16; ++r) { o0[r] *= alpha; o1[r] *= alpha; } }
#pragma unroll
            for (int s2 = 0; s2 < 2; ++s2) {
                const bf16x8 p0 = acc_frag(s0, s2), p1 = acc_frag(s1, s2);
                o0 = MFMA32(ldfrag_perm_sw<3>(Vt, 144, 0, 16 * s2, lane), p0, o0);
                o1 = MFMA32(ldfrag_perm_sw<3>(Vt, 144, 32, 16 * s2, lane), p0, o1);
                o0 = MFMA32(ldfrag_perm_sw<3>(Vt, 144, 0, 32 + 16 * s2, lane), p1, o0);
                o1 = MFMA32(ldfrag_perm_sw<3>(Vt, 144, 32, 32 + 16 * s2, lane), p1, o1);
            }
        }
        __syncthreads();
    }
#undef ATT_STAGE
    lsum += __shfl_xor(lsum, 32);
    const float inv = 1.f / lsum;
    const bf16* agp = H + qrow * HP + C_AG + h * 64;
    bf16* op = A.BR + qrow * DM + 1536 + h * 64;
    u32x2 agl[4][2];
#pragma unroll
    for (int g = 0; g < 4; ++g) { agl[g][0] = *(const u32x2*)(agp + 8 * g + 4 * hh); agl[g][1] = *(const u32x2*)(agp + 32 + 8 * g + 4 * hh); }
    asm volatile("" ::: "memory");
#pragma unroll
    for (int g = 0; g < 4; ++g) {
        const int d0 = 8 * g + 4 * hh;
        { const u32x2 ag = agl[g][0];
          u32x2 w; w.x = pk2(silu(bflo(ag.x)) * o0[4 * g] * inv, silu(bfhi(ag.x)) * o0[4 * g + 1] * inv);
          w.y = pk2(silu(bflo(ag.y)) * o0[4 * g + 2] * inv, silu(bfhi(ag.y)) * o0[4 * g + 3] * inv);
          *(u32x2*)(op + d0) = w; }
        { const u32x2 ag = agl[g][1];
          u32x2 w; w.x = pk2(silu(bflo(ag.x)) * o1[4 * g] * inv, silu(bfhi(ag.x)) * o1[4 * g + 1] * inv);
          w.y = pk2(silu(bflo(ag.y)) * o1[4 * g + 2] * inv, silu(bfhi(ag.y)) * o1[4 * g + 3] * inv);
          *(u32x2*)(op + 32 + d0) = w; }
    }
}

__device__ __forceinline__ void gmlp_prompt_unit(const MixArgs& A, int unit, LAS uchar* lds, int tid, int lane, int wave) {
    const int g = unit & 3, blk = (unit >> 2) & 15, b = unit >> 6;
    LAS uchar* Wm = lds; LAS uchar* Yt = lds + 34816; LAS float* bsl = (LAS float*)(lds + 69632);
    const bf16* H = A.H;
    const size_t r0 = (size_t)b * SEQ + blk * 128;
    __syncthreads();
    LAS uchar* Nat = lds + 70656;
    {
        const int j0 = (lane & 31) * 4;
        f32x4 wa[8];
#pragma unroll
        for (int q = 0; q < 8; ++q) { const int i = wave * 16 + q * 2 + (lane >> 5); wa[q] = *(const f32x4*)(A.gws + ((size_t)g * 128 + i) * 128 + j0); }
        asm volatile("" ::: "memory");
#pragma unroll
        for (int q = 0; q < 8; ++q) { const int i = wave * 16 + q * 2 + (lane >> 5); const f32x4 a = wa[q];
            *(LAS u32x2*)(Wm + i * 272 + j0 * 2) = (u32x2){pk2(a.x, a.y), pk2(a.z, a.w)}; }
        if (tid < 128) bsl[tid] = A.gbs[g * 128 + tid];
    }
    {
        const int l15 = lane & 15, rs4 = lane >> 4;
        const f32x4 lg0 = *(const f32x4*)(A.ln_g + g * 128 + l15 * 8), lg1 = *(const f32x4*)(A.ln_g + g * 128 + l15 * 8 + 4);
        const f32x4 lb0 = *(const f32x4*)(A.ln_b + g * 128 + l15 * 8), lb1 = *(const f32x4*)(A.ln_b + g * 128 + l15 * 8 + 4);
        u32x4 v[4][4];
#pragma unroll
        for (int gq = 0; gq < 4; ++gq) { const bf16* mp = H + (r0 + wave * 16 + gq * 4 + rs4) * HP + C_MV + l15 * 8;
#pragma unroll
            for (int i = 0; i < 4; ++i) v[gq][i] = *(const u32x4*)(mp + i * 128); }
#pragma unroll
        for (int gq = 0; gq < 4; ++gq) {
            float sm = 0.f, ss = 0.f;
#pragma unroll
            for (int i = 0; i < 4; ++i) { const u32x4 t = v[gq][i];
                const float x0 = bflo(t.x), x1 = bfhi(t.x), x2 = bflo(t.y), x3 = bfhi(t.y), x4 = bflo(t.z), x5 = bfhi(t.z), x6 = bflo(t.w), x7 = bfhi(t.w);
                sm += ((x0 + x1) + (x2 + x3)) + ((x4 + x5) + (x6 + x7));
                ss += ((x0 * x0 + x1 * x1) + (x2 * x2 + x3 * x3)) + ((x4 * x4 + x5 * x5) + (x6 * x6 + x7 * x7)); }
#pragma unroll
            for (int o = 1; o < 16; o <<= 1) { sm += __shfl_xor(sm, o); ss += __shfl_xor(ss, o); }
            const float mean = sm * (1.f / 512.f); float var = ss * (1.f / 512.f) - mean * mean; var = var < 0.f ? 0.f : var;
            const float rstd = __builtin_amdgcn_rsqf(var + NORM_EPS);
            const u32x4 t = (g == 0) ? v[gq][0] : (g == 1) ? v[gq][1] : (g == 2) ? v[gq][2] : v[gq][3];
            u32x4 w;
            w.x = pk2((bflo(t.x) - mean) * rstd * lg0.x + lb0.x, (bfhi(t.x) - mean) * rstd * lg0.y + lb0.y); w.y = pk2((bflo(t.y) - mean) * rstd * lg0.z + lb0.z, (bfhi(t.y) - mean) * rstd * lg0.w + lb0.w);
            w.z = pk2((bflo(t.z) - mean) * rstd * lg1.x + lb1.x, (bfhi(t.z) - mean) * rstd * lg1.y + lb1.y); w.w = pk2((bflo(t.w) - mean) * rstd * lg1.z + lb1.z, (bfhi(t.w) - mean) * rstd * lg1.w + lb1.w);
            *(LAS u32x4*)(Nat + (wave * 16 + gq * 4 + rs4) * 272 + l15 * 16) = w; }
    }
    __syncthreads();
    {
        const int row = tid & 127, c0 = (tid >> 7) * 32;
#pragma unroll
        for (int q = 0; q < 4; ++q) { const u32x4 t = *(const LAS u32x4*)(Nat + row * 272 + (c0 + 8 * q) * 2);
            const unsigned tv[4] = {t.x, t.y, t.z, t.w};
#pragma unroll
            for (int k = 0; k < 4; ++k) { *(LAS bf16*)(Yt + (c0 + 8 * q + 2 * k) * 272 + row * 2) = (bf16)(tv[k] & 0xffffu); *(LAS bf16*)(Yt + (c0 + 8 * q + 2 * k + 1) * 272 + row * 2) = (bf16)(tv[k] >> 16); } }
    }
    __syncthreads();
    const int ib = wave >> 1, hh = lane >> 5;
    const int kmax = (ib < 2) ? 64 : 128;
    const int i = 32 * ib + (lane & 31);
    const size_t row = r0 + i;
    u32x2 mgl[2][4], mul_[2][4];
#pragma unroll
    for (int cc = 0; cc < 2; ++cc)
#pragma unroll
        for (int q = 0; q < 4; ++q) { const int ch = g * 128 + 32 * ((wave & 1) * 2 + cc) + 8 * q + 4 * hh;
            mgl[cc][q] = *(const u32x2*)(H + row * HP + C_MG + ch); mul_[cc][q] = *(const u32x2*)(H + row * HP + C_MU + ch); }
#pragma unroll
    for (int cc = 0; cc < 2; ++cc) {
        const int cb = (wave & 1) * 2 + cc;
        f32x16 acc = {};
        for (int k0 = 0; k0 < kmax; k0 += 16) acc = MFMA32(ldfrag(Yt, 272, 32 * cb, k0, lane), ldfrag(Wm, 272, 32 * ib, k0, lane), acc);
        const float bsi = bsl[i];
        u32x2 mgv[4], muv[4];
#pragma unroll
        for (int q = 0; q < 4; ++q) { mgv[q] = mgl[cc][q]; muv[q] = mul_[cc][q]; }
#pragma unroll
        for (int q = 0; q < 4; ++q) { const int ch = g * 128 + 32 * cb + 8 * q + 4 * hh;
            u32x2 w; w.x = pk2(silu(bflo(mgv[q].x)) * bflo(muv[q].x) * (acc[4 * q] + bsi), silu(bfhi(mgv[q].x)) * bfhi(muv[q].x) * (acc[4 * q + 1] + bsi));
            w.y = pk2(silu(bflo(mgv[q].y)) * bflo(muv[q].y) * (acc[4 * q + 2] + bsi), silu(bfhi(mgv[q].y)) * bfhi(muv[q].y) * (acc[4 * q + 3] + bsi));
            *(u32x2*)(A.BR + row * DM + 1024 + ch) = w; }
    }
}

__device__ __forceinline__ void conv_prompt_unit(const MixArgs& A, int unit, int tid) {
    const bf16* H = A.H;
    const int r0 = unit * 64, b = r0 / SEQ, t0 = r0 % SEQ;
    const int ch0 = (tid & 63) * 8, ro = tid >> 6;
    float w0[8], w1[8], w2[8];
#pragma unroll
    for (int k = 0; k < 8; ++k) { w0[k] = A.conv_w[ch0 + k]; w1[k] = A.conv_w[512 + ch0 + k]; w2[k] = A.conv_w[1024 + ch0 + k]; }
    float zm2[8], zm1[8];
    const int tt0 = t0 + ro * 8;
    if (tt0 >= 2) {
        const size_t ra = (size_t)b * SEQ + tt0 - 2;
        const u32x4 c2 = *(const u32x4*)(H + ra * HP + C_CC + ch0), x2 = *(const u32x4*)(H + ra * HP + C_CX + ch0);
        const u32x4 c1 = *(const u32x4*)(H + (ra + 1) * HP + C_CC + ch0), x1 = *(const u32x4*)(H + (ra + 1) * HP + C_CX + ch0);
        zm2[0] = bflo(c2.x) * bflo(x2.x); zm2[1] = bfhi(c2.x) * bfhi(x2.x); zm2[2] = bflo(c2.y) * bflo(x2.y); zm2[3] = bfhi(c2.y) * bfhi(x2.y);
        zm2[4] = bflo(c2.z) * bflo(x2.z); zm2[5] = bfhi(c2.z) * bfhi(x2.z); zm2[6] = bflo(c2.w) * bflo(x2.w); zm2[7] = bfhi(c2.w) * bfhi(x2.w);
        zm1[0] = bflo(c1.x) * bflo(x1.x); zm1[1] = bfhi(c1.x) * bfhi(x1.x); zm1[2] = bflo(c1.y) * bflo(x1.y); zm1[3] = bfhi(c1.y) * bfhi(x1.y);
        zm1[4] = bflo(c1.z) * bflo(x1.z); zm1[5] = bfhi(c1.z) * bfhi(x1.z); zm1[6] = bflo(c1.w) * bflo(x1.w); zm1[7] = bfhi(c1.w) * bfhi(x1.w);
    } else {
#pragma unroll
        for (int k = 0; k < 8; ++k) { zm2[k] = 0.f; zm1[k] = 0.f; }
    }
#pragma unroll
    for (int hf = 0; hf < 2; ++hf) {
        u32x4 lcc[4], lcx[4], lcb[4], lcg[4];
#pragma unroll
        for (int k4 = 0; k4 < 4; ++k4) { const size_t row = (size_t)b * SEQ + tt0 + hf * 4 + k4;
            lcc[k4] = *(const u32x4*)(H + row * HP + C_CC + ch0); lcx[k4] = *(const u32x4*)(H + row * HP + C_CX + ch0);
            lcb[k4] = *(const u32x4*)(H + row * HP + C_CB + ch0); lcg[k4] = *(const u32x4*)(H + row * HP + C_CG + ch0); }
        asm volatile("" ::: "memory");
#pragma unroll
    for (int k4 = 0; k4 < 4; ++k4) {
        const int tt = tt0 + hf * 4 + k4; const size_t row = (size_t)b * SEQ + tt;
        const u32x4 cc = lcc[k4], cx = lcx[k4], cb = lcb[k4], cg = lcg[k4];
        float z[8], bv[8], gv[8], o[8];
        z[0] = bflo(cc.x) * bflo(cx.x); z[1] = bfhi(cc.x) * bfhi(cx.x); z[2] = bflo(cc.y) * bflo(cx.y); z[3] = bfhi(cc.y) * bfhi(cx.y);
        z[4] = bflo(cc.z) * bflo(cx.z); z[5] = bfhi(cc.z) * bfhi(cx.z); z[6] = bflo(cc.w) * bflo(cx.w); z[7] = bfhi(cc.w) * bfhi(cx.w);
        bv[0] = bflo(cb.x); bv[1] = bfhi(cb.x); bv[2] = bflo(cb.y); bv[3] = bfhi(cb.y); bv[4] = bflo(cb.z); bv[5] = bfhi(cb.z); bv[6] = bflo(cb.w); bv[7] = bfhi(cb.w);
        gv[0] = bflo(cg.x); gv[1] = bfhi(cg.x); gv[2] = bflo(cg.y); gv[3] = bfhi(cg.y); gv[4] = bflo(cg.z); gv[5] = bfhi(cg.z); gv[6] = bflo(cg.w); gv[7] = bfhi(cg.w);
#pragma unroll
        for (int k = 0; k < 8; ++k) { const float y = w0[k] * zm2[k] + w1[k] * zm1[k] + w2[k] * z[k]; o[k] = silu(gv[k]) * (bv[k] * y); }
        u32x4 w; w.x = pk2(o[0], o[1]); w.y = pk2(o[2], o[3]); w.z = pk2(o[4], o[5]); w.w = pk2(o[6], o[7]);
        *(u32x4*)(A.BR + row * DM + 512 + ch0) = w;
        if (tt >= SEQ - 2) { float* sp = A.out + O_PCONV + (((size_t)A.l * NB + b) * 2 + (tt - (SEQ - 2))) * 512 + ch0;
            *(f32x4*)sp = (f32x4){z[0], z[1], z[2], z[3]}; *(f32x4*)(sp + 4) = (f32x4){z[4], z[5], z[6], z[7]}; }
#pragma unroll
        for (int k = 0; k < 8; ++k) { zm2[k] = zm1[k]; zm1[k] = z[k]; }
    }
    }
}

__device__ __forceinline__ u32x4 kv_copy_load(const MixArgs& A, int item) {
    const int e = item & 63, kv = (item >> 6) & 1, t = (item >> 7) & 511, b = item >> 16;
    const size_t row = (size_t)b * SEQ + (SEQ - 512) + t;
    return *(const u32x4*)(A.H + row * HP + (kv ? C_AV : C_AK) + e * 8);
}
__device__ __forceinline__ void kv_copy_store(const MixArgs& A, int item, u32x4 v) {
    const int e = item & 63, kv = (item >> 6) & 1, t = (item >> 7) & 511, b = item >> 16;
    float* op = A.out + (kv ? O_PV : O_PK) + (((size_t)A.l * NB + b) * 512 + t) * 512 + e * 8;
    __builtin_nontemporal_store((f32x4){bflo(v.x), bfhi(v.x), bflo(v.y), bfhi(v.y)}, (f32x4*)op); __builtin_nontemporal_store((f32x4){bflo(v.z), bfhi(v.z), bflo(v.w), bfhi(v.w)}, (f32x4*)(op + 4));
}

struct RuLd { u32x2 a, bb; u32x4 v0, v1; };
__device__ __forceinline__ void ru_load(const MixArgs& A, int unit, int tid, RuLd& L) {
    const int c = unit & 31, h = (unit >> 5) & 3, b = unit >> 7, j = tid >> 3, pp = tid & 7;
    const bf16* rp = A.H + ((size_t)b * SEQ + c * 64 + j) * HP;
    L.a = *(const u32x2*)(rp + C_RK + h * 64 + pp * 4); L.bb = *(const u32x2*)(rp + C_RK + h * 64 + 32 + pp * 4);
    L.v0 = *(const u32x4*)(rp + C_RV + h * 128 + pp * 16); L.v1 = *(const u32x4*)(rp + C_RV + h * 128 + pp * 16 + 8);
}
__device__ __forceinline__ void ret_u_unit(const MixArgs& A, int unit, int nxt, RuLd& L, LAS uchar* lds, int tid, int lane, int wave) {
    const int c = unit & 31, h = (unit >> 5) & 3, b = unit >> 7;
    const bf16* H = A.H;
    LAS uchar* Xt = lds; LAS uchar* Yt = lds + 9216;
    const float l2g = __builtin_amdgcn_logf(1.f - ex2(-5.f - (float)h));
    __syncthreads();
    {
        const int j = tid >> 3, pp = tid & 7, i0 = pp * 4, js = (j ^ (pp << 3)) * 2;
        const u32x2 a = L.a, bb = L.bb; const u32x4 v0 = L.v0, v1 = L.v1;
        const float x1[4] = {bflo(a.x), bfhi(a.x), bflo(a.y), bfhi(a.y)}, x2[4] = {bflo(bb.x), bfhi(bb.x), bflo(bb.y), bfhi(bb.y)};
        const float sc = 0.125f * ex2((float)(63 - j) * l2g);
#pragma unroll
        for (int k = 0; k < 4; ++k) { float cs, sn; rot_cs(c * 64 + j, i0 + k, cs, sn);
            *(LAS bf16*)(Xt + (i0 + k) * 144 + js) = f2bf((x1[k] * cs - x2[k] * sn) * sc);
            *(LAS bf16*)(Xt + (32 + i0 + k) * 144 + js) = f2bf((x1[k] * sn + x2[k] * cs) * sc); }
        const unsigned vv[8] = {v0.x, v0.y, v0.z, v0.w, v1.x, v1.y, v1.z, v1.w};
#pragma unroll
        for (int k = 0; k < 8; ++k) { *(LAS bf16*)(Yt + (pp * 16 + 2 * k) * 144 + js) = (bf16)(vv[k] & 0xffffu); *(LAS bf16*)(Yt + (pp * 16 + 2 * k + 1) * 144 + js) = (bf16)(vv[k] >> 16); }
    }
    if (nxt >= 0) ru_load(A, nxt, tid, L);
    __syncthreads();
    const int kb = wave >> 2, vb = wave & 3, hh = lane >> 5;
    f32x16 acc = {};
#pragma unroll
    for (int ks = 0; ks < 4; ++ks) acc = MFMA32(ldfrag_sw<4>(Yt, 144, 32 * vb, 16 * ks, lane), ldfrag_sw<2>(Xt, 144, 32 * kb, 16 * ks, lane), acc);
    float* up = A.U + (size_t)unit * 8192 + 32 * kb + (lane & 31);
#pragma unroll
    for (int r = 0; r < 16; ++r) { const int vd = 32 * vb + (r & 3) + 8 * (r >> 2) + 4 * hh; up[vd * 64] = acc[r]; }
}

__device__ __forceinline__ void ret_prefix_item(const MixArgs& A, int item) {
    const int bh = item >> 12, e2 = (item & 4095) * 2, h = bh & 3, b = bh >> 2;
    const float g64 = ex2(64.f * __builtin_amdgcn_logf(1.f - ex2(-5.f - (float)h)));
    const float* up = A.U + (size_t)bh * 32 * 8192 + e2;
    unsigned* sp = (unsigned*)(A.SB + (size_t)bh * 32 * 8192 + e2);
    f32x2 u[32];
#pragma unroll
    for (int c = 0; c < 32; ++c) u[c] = __builtin_nontemporal_load((const f32x2*)(up + (size_t)c * 8192));
    f32x2 s = {0.f, 0.f};
#pragma unroll
    for (int c = 0; c < 32; ++c) { s = s * g64 + u[c]; sp[(size_t)c * 4096] = pk2(s.x, s.y); }
    const int vd = e2 >> 6, kd = e2 & 63;
    float* op = A.out + O_PRET + (((size_t)A.l * NB + b) * 4 + h) * 8192 + vd;
    __builtin_nontemporal_store(s.x, op + kd * 128); __builtin_nontemporal_store(s.y, op + (kd + 1) * 128);
}

struct RoLd { u32x2 qa, qb, ka, kb2; u32x4 v0, v1, s0, s1; };
__device__ __forceinline__ void ro_load(const MixArgs& A, int unit, int tid, RoLd& L) {
    const int c = unit & 31, h = (unit >> 5) & 3, b = unit >> 7, j = tid >> 3, pp = tid & 7;
    const bf16* rp = A.H + ((size_t)b * SEQ + c * 64 + j) * HP;
    L.qa = *(const u32x2*)(rp + C_RQ + h * 64 + pp * 4); L.qb = *(const u32x2*)(rp + C_RQ + h * 64 + 32 + pp * 4);
    L.ka = *(const u32x2*)(rp + C_RK + h * 64 + pp * 4); L.kb2 = *(const u32x2*)(rp + C_RK + h * 64 + 32 + pp * 4);
    L.v0 = *(const u32x4*)(rp + C_RV + h * 128 + pp * 16); L.v1 = *(const u32x4*)(rp + C_RV + h * 128 + pp * 16 + 8);
    L.s0 = (u32x4){0u, 0u, 0u, 0u}; L.s1 = (u32x4){0u, 0u, 0u, 0u};
    if (c > 0) { const u32x4* sp = (const u32x4*)(A.SB + (size_t)(unit - 1) * 8192 + (tid >> 2) * 64 + (tid & 3) * 16); L.s0 = sp[0]; L.s1 = sp[1]; }
}
__device__ __forceinline__ void ret_out_unit(const MixArgs& A, int unit, int nxt, RoLd& L, LAS uchar* lds, int tid, int lane, int wave) {
    const int c = unit & 31, h = (unit >> 5) & 3, b = unit >> 7;
    const bf16* H = A.H;
    LAS uchar* Qs = lds; LAS uchar* Qd = lds + 9216; LAS uchar* Ks = lds + 18432; LAS uchar* Vt = lds + 27648; LAS uchar* St = lds + 46080;
    LAS float* part = (LAS float*)(lds + 64512);
    const size_t r0 = (size_t)b * SEQ + c * 64;
    const float l2g = __builtin_amdgcn_logf(1.f - ex2(-5.f - (float)h));
    __syncthreads();
    {
        const int j = tid >> 3, pp = tid & 7, i0 = pp * 4, js = (j ^ (pp << 3)) * 2;
        const u32x2 qa = L.qa, qb = L.qb, ka = L.ka, kb2 = L.kb2; const u32x4 v0 = L.v0, v1 = L.v1;
        const float q1[4] = {bflo(qa.x), bfhi(qa.x), bflo(qa.y), bfhi(qa.y)}, q2[4] = {bflo(qb.x), bfhi(qb.x), bflo(qb.y), bfhi(qb.y)};
        const float k1[4] = {bflo(ka.x), bfhi(ka.x), bflo(ka.y), bfhi(ka.y)}, k2[4] = {bflo(kb2.x), bfhi(kb2.x), bflo(kb2.y), bfhi(kb2.y)};
        const float qdec = ex2((float)(j + 1) * l2g);
        float qa_[4], qb_[4], ka_[4], kb_[4];
#pragma unroll
        for (int k = 0; k < 4; ++k) { float cs, sn; rot_cs(c * 64 + j, i0 + k, cs, sn);
            qa_[k] = q1[k] * cs - q2[k] * sn; qb_[k] = q1[k] * sn + q2[k] * cs;
            ka_[k] = (k1[k] * cs - k2[k] * sn) * 0.125f; kb_[k] = (k1[k] * sn + k2[k] * cs) * 0.125f; }
        *(LAS u32x2*)(Qs + j * 144 + i0 * 2) = (u32x2){pk2(qa_[0], qa_[1]), pk2(qa_[2], qa_[3])};
        *(LAS u32x2*)(Qs + j * 144 + (32 + i0) * 2) = (u32x2){pk2(qb_[0], qb_[1]), pk2(qb_[2], qb_[3])};
        *(LAS u32x2*)(Qd + j * 144 + i0 * 2) = (u32x2){pk2(qa_[0] * qdec, qa_[1] * qdec), pk2(qa_[2] * qdec, qa_[3] * qdec)};
        *(LAS u32x2*)(Qd + j * 144 + (32 + i0) * 2) = (u32x2){pk2(qb_[0] * qdec, qb_[1] * qdec), pk2(qb_[2] * qdec, qb_[3] * qdec)};
        *(LAS u32x2*)(Ks + j * 144 + i0 * 2) = (u32x2){pk2(ka_[0], ka_[1]), pk2(ka_[2], ka_[3])};
        *(LAS u32x2*)(Ks + j * 144 + (32 + i0) * 2) = (u32x2){pk2(kb_[0], kb_[1]), pk2(kb_[2], kb_[3])};
        const unsigned vv[8] = {v0.x, v0.y, v0.z, v0.w, v1.x, v1.y, v1.z, v1.w};
#pragma unroll
        for (int k = 0; k < 8; ++k) { *(LAS bf16*)(Vt + (pp * 16 + 2 * k) * 144 + js) = (bf16)(vv[k] & 0xffffu); *(LAS bf16*)(Vt + (pp * 16 + 2 * k + 1) * 144 + js) = (bf16)(vv[k] >> 16); }
    }
    {
        const int vd = tid >> 2, part = tid & 3;
        *(LAS u32x4*)(St + vd * 144 + part * 32) = L.s0; *(LAS u32x4*)(St + vd * 144 + part * 32 + 16) = L.s1;
    }
    if (nxt >= 0) ro_load(A, nxt, tid, L);
    __syncthreads();
    const int ib = wave & 1, vb = wave >> 1, hh = lane >> 5;
    const int i = 32 * ib + (lane & 31);
    u32x2 rgl[4];
#pragma unroll
    for (int g = 0; g < 4; ++g) rgl[g] = *(const u32x2*)(H + (r0 + i) * HP + C_RG + h * 128 + 32 * vb + 8 * g + 4 * hh);
    f32x16 acc = {};
    for (int jb = 0; jb <= ib; ++jb) {
        f32x16 t = {};
#pragma unroll
        for (int ks = 0; ks < 4; ++ks) t = MFMA32(ldfrag(Ks, 144, 32 * jb, 16 * ks, lane), ldfrag(Qs, 144, 32 * ib, 16 * ks, lane), t);
#pragma unroll
        for (int r = 0; r < 16; ++r) { const int j = 32 * jb + (r & 3) + 8 * (r >> 2) + 4 * hh; t[r] = (i >= j) ? t[r] * ex2((float)(i - j) * l2g) : 0.f; }
#pragma unroll
        for (int s2 = 0; s2 < 2; ++s2) acc = MFMA32(ldfrag_perm_sw<4>(Vt, 144, 32 * vb, 32 * jb + 16 * s2, lane), acc_frag(t, s2), acc);
    }
#pragma unroll
    for (int ks = 0; ks < 4; ++ks) acc = MFMA32(ldfrag(St, 144, 32 * vb, 16 * ks, lane), ldfrag(Qd, 144, 32 * ib, 16 * ks, lane), acc);
    float s1 = 0.f, s2 = 0.f;
#pragma unroll
    for (int r = 0; r < 16; ++r) { s1 += acc[r]; s2 += acc[r] * acc[r]; }
    s1 += __shfl_xor(s1, 32); s2 += __shfl_xor(s2, 32);
    if (hh == 0) { part[(vb * 64 + i) * 2] = s1; part[(vb * 64 + i) * 2 + 1] = s2; }
    __syncthreads();
    float ts = 0.f, tss = 0.f;
#pragma unroll
    for (int p = 0; p < 4; ++p) { ts += part[(p * 64 + i) * 2]; tss += part[(p * 64 + i) * 2 + 1]; }
    const float mean = ts * (1.f / 128.f); float var = tss * (1.f / 128.f) - mean * mean; var = var < 0.f ? 0.f : var;
    const float rstd = __builtin_amdgcn_rsqf(var + NORM_EPS);
    bf16* op = A.BR + (r0 + i) * DM + h * 128 + 32 * vb;
#pragma unroll
    for (int g = 0; g < 4; ++g) { const int d0 = 8 * g + 4 * hh;
        const u32x2 rg = rgl[g];
        u32x2 w; w.x = pk2(silu(bflo(rg.x)) * (acc[4 * g] - mean) * rstd, silu(bfhi(rg.x)) * (acc[4 * g + 1] - mean) * rstd);
        w.y = pk2(silu(bflo(rg.y)) * (acc[4 * g + 2] - mean) * rstd, silu(bfhi(rg.y)) * (acc[4 * g + 3] - mean) * rstd);
        *(u32x2*)(op + d0) = w; }
}

__device__ __forceinline__ void ret_sample_unit(const MixArgs& A, int unit, LAS uchar* lds, int tid) {
    const int h = unit & 3, b = unit >> 2;
    const bf16* H = A.H;
    LAS float* q = (LAS float*)lds; LAS float* k = q + 1024; LAS float* v = k + 1024; LAS float* inner = v + 2048; LAS float* opart = inner + 256;
    const size_t r0 = (size_t)MP + b * DS;
    const float l2g = __builtin_amdgcn_logf(1.f - ex2(-5.f - (float)h));
    __syncthreads();
    { const int i = tid >> 5, pi = tid & 31;
      const bf16* qp = H + (r0 + i) * HP + C_RQ + h * 64; const bf16* kp = H + (r0 + i) * HP + C_RK + h * 64;
      float cs, sn; rot_cs(SEQ + i, pi, cs, sn);
      const float q1 = bf2f(qp[pi]), q2 = bf2f(qp[32 + pi]), k1 = bf2f(kp[pi]), k2 = bf2f(kp[32 + pi]);
      q[i * 64 + pi] = q1 * cs - q2 * sn; q[i * 64 + 32 + pi] = q1 * sn + q2 * cs;
      k[i * 64 + pi] = (k1 * cs - k2 * sn) * 0.125f; k[i * 64 + 32 + pi] = (k1 * sn + k2 * cs) * 0.125f;
#pragma unroll
      for (int e = 0; e < 4; ++e) { const int idx = tid * 4 + e, vi = idx >> 7, vd = idx & 127; v[idx] = bf2f(H[(r0 + vi) * HP + C_RV + h * 128 + vd]); } }
    __syncthreads();
    if (tid < 256) { const int i = tid >> 4, j = tid & 15; float d = 0.f;
        if (j <= i) { for (int e = 0; e < 64; ++e) d += q[i * 64 + e] * k[j * 64 + e]; d *= ex2((float)(i - j) * l2g); }
        inner[tid] = d; }
    { const int vd = tid & 127, kq = tid >> 7;
      const float* sp = A.state_ret + (((size_t)b * 4 + h) * 64 + kq * 16) * 128 + vd;
      float s[16];
#pragma unroll
      for (int kk = 0; kk < 16; ++kk) s[kk] = __builtin_nontemporal_load(sp + kk * 128);
      for (int i = 0; i < 16; ++i) { float a = 0.f;
#pragma unroll
          for (int kk = 0; kk < 16; ++kk) a += q[i * 64 + kq * 16 + kk] * s[kk];
          opart[(kq * 16 + i) * 128 + vd] = a * ex2((float)(i + 1) * l2g); }
      const float g16 = ex2(16.f * l2g);
      float* op = A.out + O_SRET + ((((size_t)A.l * DB + b) * 4 + h) * 64 + kq * 16) * 128 + vd;
      float dv[16];
#pragma unroll
      for (int j = 0; j < 16; ++j) dv[j] = ex2((float)(15 - j) * l2g) * v[j * 128 + vd];
#pragma unroll
      for (int kk = 0; kk < 16; ++kk) { float a = g16 * s[kk];
#pragma unroll
          for (int j = 0; j < 16; ++j) a += dv[j] * k[j * 64 + kq * 16 + kk];
          __builtin_nontemporal_store(a, op + kk * 128); } }
    __syncthreads();
    { const int i = tid >> 5, vq = tid & 31, vd = vq * 4;
      float o[4] = {0.f, 0.f, 0.f, 0.f};
#pragma unroll
      for (int p = 0; p < 4; ++p)
#pragma unroll
          for (int e = 0; e < 4; ++e) o[e] += opart[(p * 16 + i) * 128 + vd + e];
      for (int j = 0; j <= i; ++j) { const float w = inner[i * 16 + j];
#pragma unroll
          for (int e = 0; e < 4; ++e) o[e] += w * v[j * 128 + vd + e]; }
      float s1 = (o[0] + o[1]) + (o[2] + o[3]), s2 = (o[0] * o[0] + o[1] * o[1]) + (o[2] * o[2] + o[3] * o[3]);
#pragma unroll
      for (int m = 1; m < 32; m <<= 1) { s1 += __shfl_xor(s1, m); s2 += __shfl_xor(s2, m); }
      const float mean = s1 * (1.f / 128.f); float var = s2 * (1.f / 128.f) - mean * mean; var = var < 0.f ? 0.f : var;
      const float rstd = __builtin_amdgcn_rsqf(var + NORM_EPS);
      const u32x2 rg = *(const u32x2*)(H + (r0 + i) * HP + C_RG + h * 128 + vd);
      u32x2 w; w.x = pk2(silu(bflo(rg.x)) * (o[0] - mean) * rstd, silu(bfhi(rg.x)) * (o[1] - mean) * rstd);
      w.y = pk2(silu(bflo(rg.y)) * (o[2] - mean) * rstd, silu(bfhi(rg.y)) * (o[3] - mean) * rstd);
      *(u32x2*)(A.BR + (r0 + i) * DM + h * 128 + vd) = w; }
}

__device__ __forceinline__ void attn_sample_unit(const MixArgs& A, int unit, LAS uchar* lds, int tid, int lane, int wave) {
    const int h = unit & 7, b = unit >> 3;
    const bf16* H = A.H;
    LAS uchar* Ks = lds; LAS float* S = (LAS float*)(lds + 78336); LAS float* tb = S + 16 * 545; LAS float* inv = tb + 260; LAS float* opart = (LAS float*)lds;
    constexpr int SP = 545;
    const size_t r0 = (size_t)MP + b * DS;
    __syncthreads();
    for (int i = tid; i < 257; i += NTHR) tb[i] = A.relb[h * 257 + i];
    bf16x8 qf[4];
    { const int q = lane & 31, hh = lane >> 5;
      u32x4 tq[4];
#pragma unroll
      for (int ks = 0; ks < 4; ++ks) tq[ks] = *(const u32x4*)(H + (r0 + (q & 15)) * HP + C_AQ + h * 64 + ks * 16 + 8 * hh);
#pragma unroll
      for (int ks = 0; ks < 4; ++ks) { u32x4 t = tq[ks];
          t.x = pk2(bflo(t.x) * 0.125f, bfhi(t.x) * 0.125f); t.y = pk2(bflo(t.y) * 0.125f, bfhi(t.y) * 0.125f); t.z = pk2(bflo(t.z) * 0.125f, bfhi(t.z) * 0.125f); t.w = pk2(bflo(t.w) * 0.125f, bfhi(t.w) * 0.125f);
          if (q >= 16) t = (u32x4){0u, 0u, 0u, 0u};
          qf[ks] = __builtin_bit_cast(bf16x8, t); } }
    {
        const int l16 = tid & 15, k0 = tid >> 4;
        f32x4 kv[16];
#pragma unroll
        for (int k = 0; k < 16; ++k) kv[k] = __builtin_nontemporal_load((const f32x4*)(A.cache_k + (((size_t)b * 512 + k0 + 32 * k) * 8 + h) * 64 + l16 * 4));
#pragma unroll
        for (int k = 0; k < 16; ++k) *(LAS u32x2*)(Ks + (k0 + 32 * k) * 144 + l16 * 8) = (u32x2){pk2(kv[k].x, kv[k].y), pk2(kv[k].z, kv[k].w)};
        if (tid < 128) { const int kk = tid >> 3, part = tid & 7;
            const u32x4 t = *(const u32x4*)(H + (r0 + kk) * HP + C_AK + h * 64 + part * 8);
            *(LAS u32x4*)(Ks + (512 + kk) * 144 + part * 16) = t;
            float* ok = A.out + O_SK + ((((size_t)A.l * DB + b) * DS + kk) * 8 + h) * 64 + part * 8;
            __builtin_nontemporal_store((f32x4){bflo(t.x), bfhi(t.x), bflo(t.y), bfhi(t.y)}, (f32x4*)ok); __builtin_nontemporal_store((f32x4){bflo(t.z), bfhi(t.z), bflo(t.w), bfhi(t.w)}, (f32x4*)(ok + 4));
        } else if (tid < 256) { const int kk = (tid - 128) >> 3, part = tid & 7; *(LAS u32x4*)(Ks + (528 + kk) * 144 + part * 16) = (u32x4){0u, 0u, 0u, 0u}; }
    }
    const int d4 = (tid & 15) * 4, part = tid >> 4;
    f32x4 vv[16];
    { const float* vp = A.cache_v + (((size_t)b * 512 + part * 16) * 8 + h) * 64 + d4;
#pragma unroll
      for (int jj = 0; jj < 16; ++jj) vv[jj] = __builtin_nontemporal_load((const f32x4*)(vp + (size_t)jj * 512)); }
    const u32x2 tvn = *(const u32x2*)(H + (r0 + (part & 15)) * HP + C_AV + h * 64 + d4);
    const unsigned agv = *(const unsigned*)(H + (r0 + (tid >> 5)) * HP + C_AG + h * 64 + (tid & 31) * 2);
    __syncthreads();
    { const int q = lane & 31, hh = lane >> 5;
      for (int jb = wave; jb < 17; jb += 8) {
          f32x16 acc = {};
#pragma unroll
          for (int ks = 0; ks < 4; ++ks) acc = MFMA32(ldfrag(Ks, 144, 32 * jb, 16 * ks, lane), qf[ks], acc);
          if (q < 16) {
#pragma unroll
              for (int r = 0; r < 16; ++r) { const int j = 32 * jb + (r & 3) + 8 * (r >> 2) + 4 * hh;
                  int idx = q + 512 - j; idx = idx < -128 ? -128 : (idx > 128 ? 128 : idx);
                  if (j < 528) S[q * SP + j] = acc[r] + tb[idx + 128]; } } } }
    __syncthreads();
#pragma unroll
    for (int rr = 0; rr < 2; ++rr) { const int i = wave * 2 + rr;
        float m = -1e30f;
        for (int j = lane; j < 528; j += 64) m = fmaxf(m, S[i * SP + j]);
        m = wave_max(m);
        float s = 0.f;
        for (int j = lane; j < 528; j += 64) { const float p = fexp(S[i * SP + j] - m); S[i * SP + j] = p; s += p; }
        s = wave_sum(s);
        if (lane == 0) inv[i] = 1.f / s; }
    __syncthreads();
    {
      f32x4 o[16];
#pragma unroll
      for (int i = 0; i < 16; ++i) o[i] = (f32x4){0.f, 0.f, 0.f, 0.f};
#pragma unroll
      for (int jj = 0; jj < 16; ++jj) { const int j = part * 16 + jj;
#pragma unroll
          for (int i = 0; i < 16; ++i) o[i] += S[i * SP + j] * vv[jj]; }
      if (part < 16) { const u32x2 t = tvn;
          const f32x4 vn = {bflo(t.x), bfhi(t.x), bflo(t.y), bfhi(t.y)};
          __builtin_nontemporal_store(vn, (f32x4*)(A.out + O_SV + ((((size_t)A.l * DB + b) * DS + part) * 8 + h) * 64 + d4));
#pragma unroll
          for (int i = 0; i < 16; ++i) o[i] += S[i * SP + 512 + part] * vn; }
#pragma unroll
      for (int i = 0; i < 16; ++i) {
#pragma unroll
          for (int k = 0; k < 4; ++k) { o[i][k] += __shfl_xor(o[i][k], 16); o[i][k] += __shfl_xor(o[i][k], 32); } }
      if ((tid & 63) < 16) {
#pragma unroll
          for (int i = 0; i < 16; ++i) *(LAS f32x4*)(opart + (wave * 16 + i) * 64 + d4) = o[i]; } }
    __syncthreads();
    { const int i = tid >> 5, d2 = (tid & 31) * 2;
      float o0 = 0.f, o1 = 0.f;
#pragma unroll
      for (int p = 0; p < 8; ++p) { o0 += opart[(p * 16 + i) * 64 + d2]; o1 += opart[(p * 16 + i) * 64 + d2 + 1]; }
      const unsigned ag = agv;
      *(unsigned*)(A.BR + (r0 + i) * DM + 1536 + h * 64 + d2) = pk2(silu(bflo(ag)) * o0 * inv[i], silu(bfhi(ag)) * o1 * inv[i]); }
}

__device__ __forceinline__ void convgmlp_sample_unit(const MixArgs& A, int unit, LAS uchar* lds, int tid, int lane, int wave) {
    const int b = unit, ch = tid;
    const bf16* H = A.H;
    LAS float* st = (LAS float*)lds; LAS float* wsl = st + 32;
    const size_t r0 = (size_t)MP + b * DS;
    __syncthreads();
    for (int e = tid; e < 1024; e += NTHR) { const int g = e >> 8, i = (e >> 4) & 15, j = e & 15; wsl[e] = A.gws[((size_t)g * 128 + i) * 128 + j]; }
#pragma unroll
    for (int rr = 0; rr < 2; ++rr) { const int i = wave * 2 + rr;
        const u32x4 v = *(const u32x4*)(H + (r0 + i) * HP + C_MV + lane * 8);
        const float x[8] = {bflo(v.x), bfhi(v.x), bflo(v.y), bfhi(v.y), bflo(v.z), bfhi(v.z), bflo(v.w), bfhi(v.w)};
        float s = 0.f, ss = 0.f;
#pragma unroll
        for (int k = 0; k < 8; ++k) { s += x[k]; ss += x[k] * x[k]; }
        s = wave_sum(s); ss = wave_sum(ss);
        const float mean = s * (1.f / 512.f); float var = ss * (1.f / 512.f) - mean * mean; var = var < 0.f ? 0.f : var;
        if (lane == 0) { st[i * 2] = mean; st[i * 2 + 1] = __builtin_amdgcn_rsqf(var + NORM_EPS); } }
    __syncthreads();
    {
        const float w0 = A.conv_w[ch], w1 = A.conv_w[512 + ch], w2 = A.conv_w[1024 + ch];
        float zm2 = A.state_conv[((size_t)b * 2 + 0) * 512 + ch], zm1 = A.state_conv[((size_t)b * 2 + 1) * 512 + ch];
        bf16 hc[16], hx[16], hg[16], hb[16];
#pragma unroll
        for (int i = 0; i < 16; ++i) { const size_t row = r0 + i; hc[i] = H[row * HP + C_CC + ch]; hx[i] = H[row * HP + C_CX + ch]; hg[i] = H[row * HP + C_CG + ch]; hb[i] = H[row * HP + C_CB + ch]; }
        asm volatile("" ::: "memory");
#pragma unroll
        for (int i = 0; i < 16; ++i) { const size_t row = r0 + i;
            const float z = bf2f(hc[i]) * bf2f(hx[i]);
            const float y = w0 * zm2 + w1 * zm1 + w2 * z;
            A.BR[row * DM + 512 + ch] = f2bf(silu(bf2f(hg[i])) * (bf2f(hb[i]) * y));
            zm2 = zm1; zm1 = z; }
        float* sp = A.out + O_SCONV + ((size_t)A.l * DB + b) * 2 * 512 + ch;
        sp[0] = zm2; sp[512] = zm1;
    }
    {
        const float lg = A.ln_g[ch], lb = A.ln_b[ch];
        const int g = ch >> 7;
        float vn[16]; bf16 hv[16], hmg[16], hmu[16]; float gb[16];
#pragma unroll
        for (int i = 0; i < 16; ++i) { const size_t row = r0 + i; hv[i] = H[row * HP + C_MV + ch]; hmg[i] = H[row * HP + C_MG + ch]; hmu[i] = H[row * HP + C_MU + ch]; gb[i] = A.gbs[g * 128 + i]; }
        asm volatile("" ::: "memory");
#pragma unroll
        for (int i = 0; i < 16; ++i) { vn[i] = (bf2f(hv[i]) - st[i * 2]) * st[i * 2 + 1] * lg + lb;
            A.out[O_SGV + (((size_t)A.l * DB + b) * DS + i) * 512 + ch] = vn[i]; }
#pragma unroll
        for (int i = 0; i < 16; ++i) { float mix = gb[i];
#pragma unroll
            for (int j = 0; j < 16; ++j) mix += wsl[(g * 16 + i) * 16 + j] * vn[j];
            const size_t row = r0 + i;
            A.BR[row * DM + 1024 + ch] = f2bf(silu(bf2f(hmg[i])) * bf2f(hmu[i]) * mix); }
    }
}

struct Args { const float* in[17]; float* out; unsigned char* ws; int ph_lo, ph_hi; };
constexpr int N_PHASES = 2 + 7 * DEPTH;

__global__ void __launch_bounds__(NTHR, 2) enc_fwd(Args args) {
    extern __shared__ __attribute__((aligned(16))) unsigned char lds_raw[];
    LAS uchar* lds = (LAS uchar*)lds_raw;
    volatile LAS unsigned* MISC = (volatile LAS unsigned*)(lds + MISC_OFF);
#define LT() int tid = threadIdx.x; asm volatile("" : "+v"(tid)); const int lane = tid & 63, wave = __builtin_amdgcn_readfirstlane(tid >> 6); const int gw = bx * NWAVES + wave, NGW = G * NWAVES; (void)lane; (void)gw; (void)NGW
    const int G = gridDim.x, bx = blockIdx.x;
    typedef const Args __attribute__((address_space(4))) CArgs;
    gu32* ctl; { CArgs* ap0 = (CArgs*)__builtin_amdgcn_kernarg_segment_ptr(); ctl = (gu32*)(ap0->ws + WS_CTL); }
    for (int u = threadIdx.x; u < (LDS_BYTES - LDSCTL_OFF) / 4; u += NTHR) ((LAS unsigned*)(lds + LDSCTL_OFF))[u] = 0u;
    __syncthreads();
    if (!MK_SPLIT) (void)xcd_barrier_post((unsigned*)(ctl + CW_BAR), MISC + 8);
#define GRID_BAR() do { if (MK_SPLIT) { } else { CArgs* apb = (CArgs*)__builtin_amdgcn_kernarg_segment_ptr(); asm volatile("" : "+s"(apb)); XcdBarrier bar_; \
        bar_.bar = (unsigned*)(apb->ws + WS_CTL) + CW_BAR; bar_.x = xb_xcc_id(); bar_.st = (volatile LAS unsigned*)(lds + MISC_OFF) + 8; xcd_barrier(bar_); } } while (0)
    int lo, hi; { CArgs* ap0 = (CArgs*)__builtin_amdgcn_kernarg_segment_ptr(); lo = ap0->ph_lo; hi = ap0->ph_hi; }
#define IN(k) (lo <= (k) && (k) < hi)
#define BOTH(k) (IN(k) && IN((k) + 1))

#define PA() CArgs* ap = (CArgs*)__builtin_amdgcn_kernarg_segment_ptr(); asm volatile("" : "+s"(ap)); unsigned char* const ws = ap->ws; float* const X = (float*)(ws + WS_X); \
    bf16* const WinT = (bf16*)(ws + WS_WIN); bf16* const WbT = (bf16*)(ws + WS_WB); bf16* const WoT = (bf16*)(ws + WS_WO); \
    bf16* const XN = (bf16*)(ws + WS_XN); bf16* const BR = (bf16*)(ws + WS_BR); bf16* const H2 = (bf16*)(ws + WS_H2); bf16* const Hb = (bf16*)(ws + WS_H); \
    float* const Ub = (float*)(ws + WS_U); bf16* const SBb = (bf16*)(ws + WS_SB); \
    (void)X; (void)WinT; (void)WbT; (void)WoT; (void)XN; (void)BR; (void)H2; (void)Hb; (void)Ub; (void)SBb

    if (IN(0)) {
        LT(); PA();
        LAS float* scr = (LAS float*)(lds + wave * 16384);
        constexpr int I_IN = 32 * 160, I_B = 4 * 8 * 64, I_O = 32 * 64, I_L = I_IN + I_B + I_O;
        for (int it = bx; it < DEPTH * 320; it += G) {
            const int l = it / 320, j = it - l * 320; const bool gate = j >= 64;
            const int n0 = gate ? C_GL + (j - 64) * 32 : (int)((0xD962u >> (4 * (j >> 4))) & 15u) * 512 + (j & 15) * 32;
            quantw_item(ap->in[7] + (size_t)l * DM * HP, n0, ap->in[6] + (size_t)l * DM, (signed char*)(ws + WS_WIN) + ((size_t)l * HP + NBF) * DM * 2, (float*)(ws + WS_SW) + l * NQ,
                        gate, gate ? n0 - C_GL : in_pos(n0) - NBF, (LAS float*)lds, tid); }
        {
            constexpr int NIT = DEPTH * I_L;
            auto t_load = [&](int it, float (&w)[32], float& g, int& fl, bf16*& dst) {
                const int l = it / I_L; int r = it - l * I_L; const float* src; const float* gq; int ldw;
                if (r < I_IN) { const int kb = r / 160, pos0 = (r - kb * 160) * 32;
                    const int n0 = (int)((0xA7310548CBULL >> (4 * (pos0 >> 9))) & 15ULL) * 512 + (pos0 & 511);
                    src = ap->in[7] + ((size_t)l * DM + kb * 64) * HP + n0; ldw = HP; dst = WinT + ((size_t)l * HP + pos0) * DM + kb * 64; gq = ap->in[6] + (size_t)l * DM + kb * 64; fl = 1; }
                else if (r < I_IN + I_B) { r -= I_IN; const int i = r >> 9, rr = r & 511, kb = rr >> 6, nb = rr & 63;
                    src = ap->in[8] + (((size_t)l * 4 + i) * 512 + kb * 64) * DM + nb * 32; ldw = DM; dst = WbT + ((size_t)l * DM + nb * 32) * DM + i * 512 + kb * 64; gq = ap->in[6]; fl = 0; }
                else { r -= I_IN + I_B; const int kb = r >> 6, nb = r & 63;
                    src = ap->in[9] + ((size_t)l * DM + kb * 64) * DM + nb * 32; ldw = DM; dst = WoT + ((size_t)l * DM + nb * 32) * DM + kb * 64; gq = ap->in[6]; fl = 0; }
                const float* sp = src + (size_t)(lane >> 5) * ldw + (lane & 31);
#pragma unroll
                for (int i = 0; i < 32; ++i) w[i] = __builtin_nontemporal_load(sp + (size_t)(2 * i) * ldw);
                g = gq[lane];
            };
            auto t_proc = [&](const float (&w)[32], float g0, int fl, bf16* dst) {
#pragma unroll
                for (int i = 0; i < 32; ++i) scr[(2 * i + (lane >> 5)) * 33 + (lane & 31)] = w[i];
                const float g = fl ? g0 : 1.f; const int c = lane & 7; float gk[8];
#pragma unroll
                for (int e = 0; e < 8; ++e) gk[e] = __shfl(g, 8 * c + e);
                asm volatile("s_waitcnt lgkmcnt(0)" ::: "memory");
#pragma unroll
                for (int j = 0; j < 4; ++j) { const int n = (lane >> 3) + 8 * j; const LAS float* sq = scr + (8 * c) * 33 + n;
                    u32x4 o; o.x = pk2(sq[0 * 33] * gk[0], sq[1 * 33] * gk[1]); o.y = pk2(sq[2 * 33] * gk[2], sq[3 * 33] * gk[3]);
                    o.z = pk2(sq[4 * 33] * gk[4], sq[5 * 33] * gk[5]); o.w = pk2(sq[6 * 33] * gk[6], sq[7 * 33] * gk[7]);
                    __builtin_nontemporal_store(o, (u32x4*)(dst + (size_t)n * DM + 8 * c)); }
                asm volatile("s_waitcnt lgkmcnt(0)" ::: "memory");
            };
            float wa[32], wb[32], ga, gb; int fa, fb; bf16* da; bf16* db;
            int it = gw;
            if (it < NIT) {
                t_load(it, wa, ga, fa, da);
                while (true) {
                    const int i1 = it + NGW; const bool m1 = i1 < NIT;
                    t_load(m1 ? i1 : it, wb, gb, fb, db); __builtin_amdgcn_sched_barrier(0);
                    t_proc(wa, ga, fa, da);
                    if (!m1) break;
                    const int i2 = i1 + NGW; const bool m2 = i2 < NIT;
                    t_load(m2 ? i2 : i1, wa, ga, fa, da); __builtin_amdgcn_sched_barrier(0);
                    t_proc(wb, gb, fb, db);
                    if (!m2) break;
                    it = i2;
                }
            }
        }
        {
            auto x_load = [&](int m, f32x4 (&v)[8]) {
                const float* src = (m < MP) ? ap->in[0] + (size_t)m * DM : ap->in[1] + (size_t)(m - MP) * DM;
                const f32x4* xr = (const f32x4*)src + lane;
#pragma unroll
                for (int j = 0; j < 8; ++j) v[j] = __builtin_nontemporal_load(xr + 64 * j);
            };
            auto x_proc = [&](int m, const f32x4 (&v)[8]) {
                float sq = 0.f, am = 0.f;
#pragma unroll
                for (int j = 0; j < 8; ++j) { sq += (v[j].x * v[j].x + v[j].y * v[j].y) + (v[j].z * v[j].z + v[j].w * v[j].w);
                    am = fmaxf(fmaxf(am, fmaxf(fabsf(v[j].x), fabsf(v[j].y))), fmaxf(fabsf(v[j].z), fabsf(v[j].w))); }
                const float tot = wave_sum(sq); am = wave_max(am);
                const float inv = am > 0.f ? 127.f / am : 0.f;
                if (lane == 0) { ((float*)(ws + WS_CTL) + CW_SSQ)[m] = tot; ((float*)(ws + WS_RS))[m] = __builtin_amdgcn_rsqf(tot * (1.f / DM) + NORM_EPS) * am * (1.f / 127.f); }
                unsigned* xq = (unsigned*)((signed char*)(ws + WS_XQ) + (size_t)m * DM) + lane; u32x2* xn = (u32x2*)(XN + (size_t)m * DM) + lane;
#pragma unroll
                for (int j = 0; j < 8; ++j) { xq[64 * j] = pack_i8x4(v[j].x * inv, v[j].y * inv, v[j].z * inv, v[j].w * inv);
                    u32x2 o; o.x = pk2(v[j].x, v[j].y); o.y = pk2(v[j].z, v[j].w); xn[64 * j] = o; }
            };
            f32x4 va[8], vb[8];
            int m = gw;
            if (m < MT) {
                x_load(m, va);
                while (true) {
                    const int m1 = m + NGW; const bool k1 = m1 < MT;
                    x_load(k1 ? m1 : m, vb); __builtin_amdgcn_sched_barrier(0);
                    x_proc(m, va);
                    if (!k1) break;
                    const int m2 = m1 + NGW; const bool k2 = m2 < MT;
                    x_load(k2 ? m2 : m1, va); __builtin_amdgcn_sched_barrier(0);
                    x_proc(m1, vb);
                    if (!k2) break;
                    m = m2;
                }
            }
        }
        if (BOTH(0)) GRID_BAR();
    }

#define LL() int ll = l; asm volatile("" : "+s"(ll))
#define MKMA() LL(); PA(); MixArgs MA; \
        MA.H = Hb; MA.BR = BR; MA.out = ap->out; MA.U = Ub; MA.SB = SBb; MA.l = ll; \
        MA.state_ret = ap->in[2] + (size_t)ll * DB * 4 * 64 * 128; MA.state_conv = ap->in[3] + (size_t)ll * DB * 2 * 512; \
        MA.cache_k = ap->in[4] + (size_t)ll * DB * 512 * 512; MA.cache_v = ap->in[5] + (size_t)ll * DB * 512 * 512; \
        MA.conv_w = ap->in[10] + (size_t)ll * 3 * 512; MA.ln_g = ap->in[11] + (size_t)ll * 512; MA.ln_b = ap->in[12] + (size_t)ll * 512; \
        MA.gws = ap->in[13] + (size_t)ll * 4 * 128 * 128; MA.gbs = ap->in[14] + (size_t)ll * 4 * 128; MA.relb = ap->in[15] + (size_t)ll * 8 * 257
    for (int l = 0; l < DEPTH; ++l) {
        const int p = 2 + 7 * l;
        if (IN(p)) {
            LL(); PA();
            { pg8::Gemm g{XN, WinT + (size_t)ll * HP * DM, DM * 2, 0}; pg8::SegOrder S; S.init(MP, NBF, G, bx, 1, DM / 64);
              pg8::EpiH E{Hb, (const float*)(ws + WS_CTL) + CW_SSQ + (size_t)ll * MT};
              pg8::gemm_phase<pg8::EpiH, pg8::SegOrder, true, true>(lds, g, S, E); }
            { pg8::Gemm g{ws + WS_XQ, ws + WS_WIN + ((size_t)ll * HP + NBF) * DM * 2, DM, 0}; pg8::SegOrder S; S.init(MP, NQ, G, bx, 1, DM / 128);
              pg8::EpiHqT<false> E{Hb, (const float*)(ws + WS_RS) + (size_t)ll * MT, (const float*)(ws + WS_SW) + ll * NQ, (bf16*)(ws + WS_RB)};
              pg8::gemm_phase<pg8::EpiHqT<false>, pg8::SegOrder, true, true, true>(lds, g, S, E); }
            if (BOTH(p)) GRID_BAR();
        }
        if (IN(p + 1)) {
            MKMA();
            if (bx < 120) {
                const int spn = bx % 60;
                if (spn < NBF / 256) { pg8::Gemm g{XN, WinT + (size_t)ll * HP * DM, DM * 2, 0}; pg8::OneUnit S{MP / 256 + bx / 60, spn, 0, DM / 64};
                    pg8::EpiH E{Hb, (const float*)(ws + WS_CTL) + CW_SSQ + (size_t)ll * MT};
                    pg8::gemm_phase<pg8::EpiH, pg8::OneUnit, true, true>(lds, g, S, E); }
                else { pg8::Gemm g{ws + WS_XQ, ws + WS_WIN + ((size_t)ll * HP + NBF) * DM * 2, DM, 0}; pg8::OneUnit S{MP / 256 + bx / 60, spn - NBF / 256, 0, DM / 128};
                    pg8::EpiHqT<true> E{Hb, (const float*)(ws + WS_RS) + (size_t)ll * MT, (const float*)(ws + WS_SW) + ll * NQ, (bf16*)(ws + WS_RB)};
                    pg8::gemm_phase<pg8::EpiHqT<true>, pg8::OneUnit, true, true, true>(lds, g, S, E); }
            }
            if (bx < 120 && bx % 60 >= NBF / 256) {
                int u = (bx < 60) ? bx - NBF / 256 : bx - 60 - NBF / 256 + (60 - NBF / 256); asm volatile("" : "+s"(u));
                if (u < 64) { LT(); conv_prompt_unit(MA, u, tid); } }
            { unsigned* qc = (unsigned*)(ws + WS_CTL) + CW_Q + 64 * ll; LAS int* qs = (LAS int*)(lds + LDS_BYTES - 64);
              int qraw = 0;
              auto issue = [&]() { if (threadIdx.x == 0) qraw = (int)xb_add(qc, 1u); };
              auto take = [&]() -> int { if (threadIdx.x == 0) *qs = qraw; __syncthreads(); return __builtin_amdgcn_readfirstlane(*qs); };
              int q, qn;
              { int r0 = 0, r1 = 0; if (threadIdx.x == 0) { r0 = (int)xb_add(qc, 1u); r1 = (int)xb_add(qc, 1u); if (r1 < r0) { const int t = r0; r0 = r1; r1 = t; } qs[0] = r0; qs[1] = r1; }
                __syncthreads(); q = __builtin_amdgcn_readfirstlane(qs[0]); qn = __builtin_amdgcn_readfirstlane(qs[1]); __syncthreads(); }
              while (q < 1024) { issue();
                  if (q < 512) { LT(); attn_prompt_unit(MA, q, lds, tid, lane, wave); }
                  else { LT(); gmlp_prompt_unit(MA, q - 512, lds, tid, lane, wave); }
                  q = qn; qn = take(); }
              if (q < 2048) { LT(); RuLd L; ru_load(MA, q - 1024, tid, L);
                  while (q < 2048) { issue(); ret_u_unit(MA, q - 1024, (qn < 2048) ? qn - 1024 : -1, L, lds, tid, lane, wave); q = qn; qn = take(); } } }
            if (BOTH(p + 1)) GRID_BAR();
        }
        if (IN(p + 2)) {
            MKMA();
            { LT(); for (int it = bx * NTHR + tid; it < 32 * 4096; it += G * NTHR) ret_prefix_item(MA, it); }
            for (int u = bx; u < 256; u += G) { LT(); attn_sample_unit(MA, u, lds, tid, lane, wave); }
            for (int u = bx; u < 128; u += G) { LT(); ret_sample_unit(MA, u, lds, tid); }
            for (int u = G - 1 - bx; u < 32; u += G) { LT(); convgmlp_sample_unit(MA, u, lds, tid, lane, wave); }
            if (bx >= 128 && bx < 224) {
                for (int k = 0; k < 2; ++k) { int u = 64 + 2 * (bx - 128) + k; asm volatile("" : "+s"(u)); LT(); conv_prompt_unit(MA, u, tid); } }
            __syncthreads();
            if (BOTH(p + 2)) GRID_BAR();
        }
        if (IN(p + 3)) {
            MKMA();
#define KV_BLOCKS(B0, PER) { for (int k0 = 0; k0 < (PER); k0 += 4) { u32x4 kvv[4]; \
                _Pragma("unroll") for (int k = 0; k < 4; ++k) { const int blk = (B0) + k0 + k; kvv[k] = kv_copy_load(MA, ((blk < 1024) ? blk : 1023) * NTHR + tid); } \
                _Pragma("unroll") for (int k = 0; k < 4; ++k) { const int blk = (B0) + k0 + k; if (k0 + k < (PER) && blk < 1024) kv_copy_store(MA, blk * NTHR + tid, kvv[k]); } } }
            const int nonG = G - 64, lim = (5 * nonG < 1024) ? 5 * nonG : 1024;
            if (bx >= nonG) {
                const int q = bx - nonG, t16 = q >> 2;
                pg8::Gemm g{BR, WbT + (size_t)ll * DM * DM, DM * 2, 1024}; pg8::OneUnit S{MP / 256 + (t16 >> 3), t16 & 7, q & 3, 8};
                pg8::EpiMergeS E{Hb, (float*)(ws + WS_MP)};
                pg8::gemm_phase<pg8::EpiMergeS, pg8::OneUnit, true, true>(lds, g, S, E);
                for (int u0 = lim + q; u0 < 1024; u0 += 64) { int u = u0; asm volatile("" : "+s"(u)); LT(); RoLd L; ro_load(MA, u, tid, L); ret_out_unit(MA, u, -1, L, lds, tid, lane, wave); }
                { LT(); KV_BLOCKS(2 * q, 2) }
            } else {
                { LT(); RoLd L; ro_load(MA, bx, tid, L);
                  for (int u = bx; u < lim; u += nonG) ret_out_unit(MA, u, (u + nonG < lim) ? u + nonG : -1, L, lds, tid, lane, wave); }
                { LT(); const int per = (1024 - 128 + nonG - 1) / nonG; KV_BLOCKS(128 + bx * per, per) }
            }
#undef KV_BLOCKS
            __syncthreads();
            if (BOTH(p + 3)) GRID_BAR();
        }
        if (IN(p + 4)) {
            LL(); PA();
            { LT(); const float* mp = (const float*)(ws + WS_MP);
              for (int it = bx * NTHR + tid; it < MS * DM / 8; it += G * NTHR) { const size_t e = (size_t)it * 8;
                  f32x4 a = *(const f32x4*)(mp + e), b = *(const f32x4*)(mp + e + 4);
#pragma unroll
                  for (int q = 1; q < 4; ++q) { a += *(const f32x4*)(mp + (size_t)q * MS * DM + e); b += *(const f32x4*)(mp + (size_t)q * MS * DM + e + 4); }
                  u32x4 w; w.x = pk2(a.x, a.y); w.y = pk2(a.z, a.w); w.z = pk2(b.x, b.y); w.w = pk2(b.z, b.w);
                  *(u32x4*)(H2 + (size_t)MP * DM + e) = w; } }
            pg8::Gemm g{BR, WbT + (size_t)ll * DM * DM, DM * 2, 1024}; pg8::SegOrder S; S.init(MP, DM, G, bx, 4, 8);
            pg8::EpiMerge E{(const bf16*)(ws + WS_RB), H2};
            pg8::gemm_phase<pg8::EpiMerge, pg8::SegOrder, true, true>(lds, g, S, E);
            if (BOTH(p + 4)) GRID_BAR();
        }
        if (IN(p + 5)) {
            LL(); PA();
            pg8::Gemm g{H2, WoT + (size_t)ll * DM * DM, DM * 2, 512}; pg8::OutOrder S; S.P.init(MP, DM, G, bx, 1, DM / 64); S.nP = (MP / 256) * (DM / 256) / G; S.c = bx;
            const bool fuse = (ll < DEPTH - 1);
            (void)fuse; pg8::EpiOut E{XN, (float*)(ws + WS_XP), nullptr};
            pg8::gemm_phase<pg8::EpiOut, pg8::OutOrder, true, true>(lds, g, S, E);
            if (BOTH(p + 5)) GRID_BAR();
        }
        if (IN(p + 6)) {
            LT(); LL(); PA();
            const float* XPb = (const float*)(ws + WS_XP);
#define PIPE2(LOAD, PROC) { u32x4 ta[4], tb[4]; int m = gw; if (m < MP) { LOAD(m, ta); while (true) { \
                const int m1 = m + NGW; const bool k1 = m1 < MP; LOAD(k1 ? m1 : m, tb); __builtin_amdgcn_sched_barrier(0); PROC(m, ta); if (!k1) break; \
                const int m2 = m1 + NGW; const bool k2 = m2 < MP; LOAD(k2 ? m2 : m1, ta); __builtin_amdgcn_sched_barrier(0); PROC(m1, tb); if (!k2) break; m = m2; } } }
            auto n_load = [&](int m, u32x4 (&t)[4]) { const bf16* src = XN + (size_t)m * DM + lane * 8;
#pragma unroll
                for (int j = 0; j < 4; ++j) t[j] = *(const u32x4*)(src + 512 * j); };
            if (ll < DEPTH - 1) {
                auto n_mid = [&](int m, const u32x4 (&t)[4]) {
                    f32x4 v[4][2]; float sq = 0.f, am = 0.f;
#pragma unroll
                    for (int j = 0; j < 4; ++j) { v[j][0] = (f32x4){bflo(t[j].x), bfhi(t[j].x), bflo(t[j].y), bfhi(t[j].y)}; v[j][1] = (f32x4){bflo(t[j].z), bfhi(t[j].z), bflo(t[j].w), bfhi(t[j].w)};
#pragma unroll
                        for (int hf = 0; hf < 2; ++hf) { const f32x4 a = v[j][hf]; sq += (a.x * a.x + a.y * a.y) + (a.z * a.z + a.w * a.w);
                            am = fmaxf(fmaxf(am, fmaxf(fabsf(a.x), fabsf(a.y))), fmaxf(fabsf(a.z), fabsf(a.w))); } }
                    const float tot = wave_sum(sq); am = wave_max(am);
                    const float inv = am > 0.f ? 127.f / am : 0.f;
                    if (lane == 0) { ((float*)(ws + WS_CTL) + CW_SSQ + (size_t)(ll + 1) * MT)[m] = tot; ((float*)(ws + WS_RS) + (size_t)(ll + 1) * MT)[m] = __builtin_amdgcn_rsqf(tot * (1.f / DM) + NORM_EPS) * am * (1.f / 127.f); }
                    signed char* xq = (signed char*)(ws + WS_XQ) + (size_t)m * DM + lane * 8;
#pragma unroll
                    for (int j = 0; j < 4; ++j) *(u32x2*)(xq + 512 * j) = (u32x2){pack_i8x4(v[j][0].x * inv, v[j][0].y * inv, v[j][0].z * inv, v[j][0].w * inv), pack_i8x4(v[j][1].x * inv, v[j][1].y * inv, v[j][1].z * inv, v[j][1].w * inv)};
                };
                PIPE2(n_load, n_mid)
                for (int m = MP + gw; m < MT; m += NGW)
                    norm_row_bf(XN + (size_t)m * DM, XN + (size_t)m * DM, nullptr, nullptr, lane, XPb + (size_t)(m - MP) * DM, (float*)(ws + WS_CTL) + CW_SSQ + (size_t)(ll + 1) * MT + m,
                                (signed char*)(ws + WS_XQ) + (size_t)m * DM, (float*)(ws + WS_RS) + (size_t)(ll + 1) * MT + m);
            } else {
                f32x4 gn[4][2];
#pragma unroll
                for (int j = 0; j < 4; ++j) { gn[j][0] = *(const f32x4*)(ap->in[16] + lane * 8 + 512 * j); gn[j][1] = *(const f32x4*)(ap->in[16] + lane * 8 + 512 * j + 4); }
                auto n_fin = [&](int m, const u32x4 (&t)[4]) {
                    f32x4 v[4][2]; float sq = 0.f;
#pragma unroll
                    for (int j = 0; j < 4; ++j) { v[j][0] = (f32x4){bflo(t[j].x), bfhi(t[j].x), bflo(t[j].y), bfhi(t[j].y)}; v[j][1] = (f32x4){bflo(t[j].z), bfhi(t[j].z), bflo(t[j].w), bfhi(t[j].w)};
#pragma unroll
                        for (int hf = 0; hf < 2; ++hf) { const f32x4 a = v[j][hf]; sq += (a.x * a.x + a.y * a.y) + (a.z * a.z + a.w * a.w); } }
                    const float rstd = __builtin_amdgcn_rsqf(wave_sum(sq) * (1.f / DM) + NORM_EPS);
                    float* op = ap->out + (size_t)m * DM + lane * 8;
#pragma unroll
                    for (int j = 0; j < 4; ++j) { __builtin_nontemporal_store(v[j][0] * rstd * gn[j][0], (f32x4*)(op + 512 * j)); __builtin_nontemporal_store(v[j][1] * rstd * gn[j][1], (f32x4*)(op + 512 * j + 4)); }
                };
                PIPE2(n_load, n_fin)
                for (int m = MP + gw; m < MT; m += NGW) norm_row_bf(XN + (size_t)m * DM, nullptr, ap->out + (size_t)m * DM, ap->in[16], lane, XPb + (size_t)(m - MP) * DM, nullptr);
            }
#undef PIPE2
            if (BOTH(p + 6)) GRID_BAR();
        }
    }
#undef IN
#undef BOTH
}

extern "C" void kernel_launch(void* const* d_in, const int* in_sizes, int n_in, void* d_out, int out_size, void* d_ws, size_t ws_size, hipStream_t stream) {
    static int grid = 0;
    if (grid == 0) {
        if (n_in != 17 || (size_t)out_size != O_END || ws_size < WS_END) { fprintf(stderr, "kernel_launch: unexpected sizes: n_in %d out %d ws %zu (need %zu)\n", n_in, out_size, ws_size, (size_t)WS_END); grid = -1; return; }
        int dev = 0, cus = 0, per_cu = 0;
        if (hipGetDevice(&dev) != hipSuccess || hipDeviceGetAttribute(&cus, hipDeviceAttributeMultiprocessorCount, dev) != hipSuccess) { grid = -1; return; }
        if (hipFuncSetAttribute((const void*)enc_fwd, hipFuncAttributeMaxDynamicSharedMemorySize, LDS_BYTES) != hipSuccess) { fprintf(stderr, "kernel_launch: hipFuncSetAttribute failed\n"); grid = -1; return; }
        if (hipOccupancyMaxActiveBlocksPerMultiprocessor(&per_cu, (const void*)enc_fwd, NTHR, LDS_BYTES) != hipSuccess || per_cu < 1) { fprintf(stderr, "kernel_launch: occupancy query says %d\n", per_cu); }
        (void)hipGetLastError();
        grid = cus;
        if (grid < 128) { fprintf(stderr, "kernel_launch: built for a >= 128-CU device (got %d)\n", grid); grid = -1; return; }
    }
    if (grid < 0) return;
    if (hipMemsetAsync((char*)d_ws + WS_CTL, 0, CTL_ZERO_BYTES, stream) != hipSuccess) return;
    Args a{};
    for (int i = 0; i < 17; ++i) a.in[i] = (const float*)d_in[i];
    a.out = (float*)d_out; a.ws = (unsigned char*)d_ws;
#if MK_SPLIT
    for (int ph = 0; ph < N_PHASES; ++ph) { a.ph_lo = ph; a.ph_hi = ph + 1; hipLaunchKernelGGL(enc_fwd, dim3(grid), dim3(NTHR), LDS_BYTES, stream, a); }
#else
    a.ph_lo = 0; a.ph_hi = N_PHASES;
    hipLaunchKernelGGL(enc_fwd, dim3(grid), dim3(NTHR), LDS_BYTES, stream, a);
#endif
}
```

```cpp
#include <hip/hip_runtime.h>
#include <cstdio>
#include <cstdint>
#include <type_traits>

#ifndef MK_SPLIT
#define MK_SPLIT 0
#endif

#define GAS __attribute__((address_space(1)))
#define LAS __attribute__((address_space(3)))
typedef unsigned short bf16;
typedef unsigned char uchar;
typedef unsigned u32x4 __attribute__((ext_vector_type(4)));
typedef unsigned u32x2 __attribute__((ext_vector_type(2)));
typedef float f32x4 __attribute__((ext_vector_type(4)));
typedef float f32x2 __attribute__((ext_vector_type(2)));
typedef float f32x16 __attribute__((ext_vector_type(16)));
typedef short bf16x8 __attribute__((ext_vector_type(8)));
typedef GAS unsigned gu32;
typedef int i32x4 __attribute__((ext_vector_type(4)));

constexpr int DM = 2048, NB = 8, SEQ = 2048, DEPTH = 4, DB = 32, DS = 16;
constexpr int MP = NB * SEQ, MS = DB * DS, MT = MP + MS;
constexpr int HP = 15360;
constexpr int C_AK = 0, C_AV = 512, C_MV = 1024, C_CC = 1536, C_CX = 2048, C_RQ = 2560, C_RK = 2816, C_RV = 3072, C_CB = 3584, C_MU = 4096, C_AQ = 4608,
              C_RG = 5120, C_CG = 5632, C_MG = 6144, C_AG = 6656, C_GL = 7168;
constexpr int NBF = 5120, NQ = HP - NBF, NQM = C_GL - NBF;
__host__ __device__ __forceinline__ int in_pos(int n) {
    const int b2 = n >> 9, nb = 2 * (int)((0xD109C28B437A65ULL >> (4 * b2)) & 15ULL) + ((n >> 8) & 1);
    return nb * 256 + (n & 255);
}
constexpr float NORM_EPS = 1e-6f;
constexpr float LOG2E = 1.4426950408889634f;
constexpr size_t O_Y = 0, O_PRET = 34603008, O_PCONV = 35651584, O_PK = 35684352, O_PV = 44072960, O_SRET = 52461568,
                 O_SCONV = 56655872, O_SK = 56786944, O_SV = 57835520, O_SGV = 58884096, O_END = 59932672;
constexpr size_t MiB = 1u << 20;
constexpr size_t WS_CTL = 0, CTL_ZERO_BYTES = 1 * MiB;
constexpr size_t WS_WIN = 2 * MiB, WS_WB = 242 * MiB, WS_WO = 274 * MiB, WS_XN = 306 * MiB, WS_BR = 372 * MiB, WS_H2 = 438 * MiB,
                 WS_U = 504 * MiB, WS_SB = 536 * MiB, WS_XP = 552 * MiB, WS_X = 584 * MiB, WS_H = 716 * MiB, WS_MP = 1211 * MiB, WS_SSQP = 1227 * MiB, WS_RB = 1230 * MiB, WS_END = 1495 * MiB;
static_assert(WS_WIN + (size_t)DEPTH * HP * DM * 2 <= WS_WB && WS_XN + (size_t)MT * DM * 2 <= WS_BR && WS_H + (size_t)MT * HP * 2 <= WS_END, "ws map");
constexpr int CW_BAR = 4096;
constexpr int CW_Q = 16384;
constexpr int CW_CMAX = 135168;
constexpr int CW_SSQ = 65536;
static_assert(CW_SSQ + DEPTH * MT <= CW_CMAX && (CW_CMAX + DEPTH * NQ) * 4 <= (int)CTL_ZERO_BYTES && (CW_SSQ + DEPTH * MT) * 4 <= (int)CTL_ZERO_BYTES, "SSQ inside the zeroed control region");
constexpr int RING_BYTES = 131072, LDSCTL_OFF = RING_BYTES, MISC_OFF = LDSCTL_OFF + 320, LDS_BYTES = 147456;
constexpr int NWAVES = 8, NTHR = 512;
constexpr size_t WS_XQ = 584 * MiB, WS_SW = 620 * MiB, WS_RS = 621 * MiB;
static_assert(WS_XQ + (size_t)MT * DM <= WS_SW && WS_RS + (size_t)DEPTH * MT * 4 <= 716 * MiB, "int8 buffers");

__device__ __forceinline__ float bflo(unsigned u) { return __builtin_bit_cast(float, u << 16); }
__device__ __forceinline__ float bfhi(unsigned u) { return __builtin_bit_cast(float, u & 0xffff0000u); }
__device__ __forceinline__ float bf2f(bf16 b) { return __builtin_bit_cast(float, (unsigned)b << 16); }
__device__ __forceinline__ unsigned pk2(float lo, float hi) { unsigned r; asm("v_cvt_pk_bf16_f32 %0, %1, %2" : "=v"(r) : "v"(lo), "v"(hi)); return r; }
__device__ __forceinline__ bf16 f2bf(float f) { return (bf16)(pk2(f, 0.f) & 0xffffu); }
__device__ __forceinline__ float ex2(float x) { return __builtin_amdgcn_exp2f(x); }
__device__ __forceinline__ float fexp(float x) { return __builtin_amdgcn_exp2f(x * LOG2E); }
__device__ __forceinline__ float sigm(float x) { return __builtin_amdgcn_rcpf(1.f + fexp(-x)); }
__device__ __forceinline__ float silu(float x) { return x * sigm(x); }
__device__ __forceinline__ float wave_sum(float v) {
#pragma unroll
    for (int o = 1; o < 64; o <<= 1) v += __shfl_xor(v, o);
    return v;
}
__device__ __forceinline__ float wave_max(float v) {
#pragma unroll
    for (int o = 1; o < 64; o <<= 1) v = fmaxf(v, __shfl_xor(v, o));
    return v;
}
#define MFMA32(a, b, c) __builtin_amdgcn_mfma_f32_32x32x16_bf16((a), (b), (c), 0, 0, 0)
__device__ __forceinline__ bf16x8 ldfrag(const LAS uchar* base, int pitch, int row0, int k0, int lane) {
    return *(const LAS bf16x8*)(base + (row0 + (lane & 31)) * pitch + (k0 + 8 * (lane >> 5)) * 2);
}
__device__ __forceinline__ bf16x8 ldfrag_perm(const LAS uchar* base, int pitch, int row0, int kb, int lane) {
    const LAS uchar* p = base + (row0 + (lane & 31)) * pitch + (kb + 4 * (lane >> 5)) * 2;
    const u32x2 lo = *(const LAS u32x2*)p, hi = *(const LAS u32x2*)(p + 16);
    return __builtin_bit_cast(bf16x8, (u32x4){lo.x, lo.y, hi.x, hi.y});
}
template <int SH> __device__ __forceinline__ bf16x8 ldfrag_sw(const LAS uchar* base, int pitch, int row0, int k0, int lane) {
    const int r = row0 + (lane & 31), k = (k0 + 8 * (lane >> 5)) ^ (((r >> SH) & 7) << 3);
    return *(const LAS bf16x8*)(base + r * pitch + k * 2);
}
template <int SH> __device__ __forceinline__ bf16x8 ldfrag_perm_sw(const LAS uchar* base, int pitch, int row0, int kb, int lane) {
    const int r = row0 + (lane & 31), sw = ((r >> SH) & 7) << 3, kk = kb + 4 * (lane >> 5);
    const u32x2 lo = *(const LAS u32x2*)(base + r * pitch + (kk ^ sw) * 2), hi = *(const LAS u32x2*)(base + r * pitch + ((kk + 8) ^ sw) * 2);
    return __builtin_bit_cast(bf16x8, (u32x4){lo.x, lo.y, hi.x, hi.y});
}
__device__ __forceinline__ bf16x8 acc_frag(const f32x16& x, int s) {
    u32x4 w;
    if (s == 0) { w.x = pk2(x[0], x[1]); w.y = pk2(x[2], x[3]); w.z = pk2(x[4], x[5]); w.w = pk2(x[6], x[7]); }
    else        { w.x = pk2(x[8], x[9]); w.y = pk2(x[10], x[11]); w.z = pk2(x[12], x[13]); w.w = pk2(x[14], x[15]); }
    return __builtin_bit_cast(bf16x8, w);
}
__device__ __forceinline__ void rot_cs(int pos, int i, float& c, float& s) {
    const float fr = ex2(-(float)i * (13.287712379549449f / 32.f));
    float rev = ((float)pos * fr) * 0.15915494309189535f;
    rev = rev - rintf(rev);
    c = __builtin_amdgcn_cosf(rev); s = __builtin_amdgcn_sinf(rev);
}

namespace pg8 {
#define PG8_LAS __attribute__((address_space(3)))
typedef unsigned short bf16_t;
constexpr int BM = 256, BK = 64, HALF = 128, HTB = HALF * BK * 2, NXCD = 8, WGM = 4;
__host__ __device__ __forceinline__ int lds_byte(int r, int c) { const int st = (r >> 4) * 2 + (c >> 5), rr = r & 15, cc = c & 31, ob = rr * 64 + cc * 2; return st * 1024 + (ob ^ (((ob >> 9) & 1) << 5)); }
__host__ __device__ __forceinline__ void stage_rc(int b, int& R, int& C) { const int st = b / 1024, sb = b % 1024, swz = sb ^ (((sb >> 9) & 1) << 5); R = (st >> 1) * 16 + swz / 64; C = (st & 1) * 32 + (swz % 64) / 2; }
__host__ __device__ __forceinline__ int perm32(int rho) { const int n = rho >> 4, i = rho & 15; return 8 * (i >> 2) + 4 * n + (i & 3); }

struct Unit { int pm, pn, seg, nt, mode; };
struct Gemm { const void* A; const void* Bt; int K; int segb; };

struct SegOrder {
    int nM, nN, nwg, G, c, nseg, nt;
    __device__ void init(int M, int N, int G_, int c_, int nseg_, int nt_) { nM = M / BM; nN = N / BM; nwg = nM * nN; G = G_; c = c_; nseg = nseg_; nt = nt_; }
    __device__ __forceinline__ bool next(int i, Unit& u) const {
        const int ti = i / nseg; u.seg = i - ti * nseg; u.nt = nt; u.mode = 0;
        const long L = (long)ti * G + c; if (L >= nwg) return false;
        int wgid = (int)L; { const int q = nwg / NXCD, r = nwg % NXCD, xcd = wgid % NXCD, off = wgid / NXCD; wgid = (xcd < r ? xcd * (q + 1) : r * (q + 1) + (xcd - r) * q) + off; }
        const int nig = WGM * nN, gid = wgid / nig, fm = gid * WGM, gsz = (nM - fm) < WGM ? (nM - fm) : WGM;
        u.pm = fm + ((wgid % nig) % gsz); u.pn = (wgid % nig) / gsz; return true;
    }
};

struct OneTile {
    int pm, pn, nseg, nt;
    __device__ __forceinline__ bool next(int i, Unit& u) const { if (i >= nseg) return false; int a = pm, b = pn; asm volatile("" : "+s"(a), "+s"(b));
        u.pm = a; u.pn = b; u.seg = i; u.nt = nt; u.mode = 0; return true; }
};
struct OneUnit {
    int pm, pn, seg, nt;
    __device__ __forceinline__ bool next(int i, Unit& u) const { if (i >= 1) return false; int a = pm, b = pn; asm volatile("" : "+s"(a), "+s"(b)); u.pm = a; u.pn = b; u.seg = seg; u.nt = nt; u.mode = 0; return true; }
};
struct OutOrder {
    SegOrder P; int nP, c;
    __device__ __forceinline__ bool next(int i, Unit& u) const {
        Unit t; const bool okp = P.next(i < nP ? i : 0, t);
        int a = MP / BM + (c >> 6), b = (c >> 3) & 7; asm volatile("" : "+s"(a), "+s"(b));
        const bool pr = (i < nP);
        Unit r; r.pm = pr ? t.pm : a; r.pn = pr ? t.pn : b; r.seg = pr ? 0 : (c & 7); r.nt = pr ? t.nt : 4; r.mode = pr ? 0 : 1;
        u = r;
        return pr ? okp : (i == nP && c < 128);
    }
};
struct EpiH {
    bf16* H; const float* ssq;
    static __device__ __forceinline__ bool keep(const Unit&) { return false; }
    __device__ __forceinline__ void operator()(f32x4 (&acc)[2][2][4][2], const Unit& u, int wr, int wc, int fr, int fq) const {
        const int row0 = u.pm * BM + wr * 64 + fr, col0 = u.pn * BM + wc * 32 + 8 * fq;
        float rs[2][4];
#pragma unroll
        for (int ai = 0; ai < 2; ++ai)
#pragma unroll
            for (int m = 0; m < 4; ++m) rs[ai][m] = ssq[row0 + ai * HALF + m * 16];
#pragma unroll
        for (int ai = 0; ai < 2; ++ai)
#pragma unroll
            for (int m = 0; m < 4; ++m) rs[ai][m] = __builtin_amdgcn_rsqf(rs[ai][m] * (1.f / DM) + NORM_EPS);
#pragma unroll
        for (int ai = 0; ai < 2; ++ai)
#pragma unroll
            for (int m = 0; m < 4; ++m) { bf16* rowp = H + (size_t)(row0 + ai * HALF + m * 16) * HP + col0;
#pragma unroll
                for (int bj = 0; bj < 2; ++bj) { const f32x4 v0 = acc[ai][bj][m][0] * rs[ai][m], v1 = acc[ai][bj][m][1] * rs[ai][m];
                    u32x4 w; w.x = pk2(v0[0], v0[1]); w.y = pk2(v0[2], v0[3]); w.z = pk2(v1[0], v1[1]); w.w = pk2(v1[2], v1[3]);
                    *(u32x4*)(rowp + bj * HALF) = w; } }
    }
};
template <bool SMP> struct EpiHqT {
    bf16* H; const float* rsc; const float* sw; bf16* RB;
    static __device__ __forceinline__ bool keep(const Unit&) { return false; }
    __device__ __forceinline__ void operator()(i32x4 (&acc)[2][2][4][2], const Unit& u, int wr, int wc, int fr, int fq) const {
        const int row0 = u.pm * BM + wr * 64 + fr;
        float rs[2][4];
#pragma unroll
        for (int ai = 0; ai < 2; ++ai)
#pragma unroll
            for (int m = 0; m < 4; ++m) rs[ai][m] = rsc[row0 + ai * HALF + m * 16];
        f32x4 cs[2][2];
#pragma unroll
        for (int bj = 0; bj < 2; ++bj) { const float* sp = sw + u.pn * BM + bj * HALF + wc * 32 + 8 * fq; cs[bj][0] = *(const f32x4*)sp; cs[bj][1] = *(const f32x4*)(sp + 4); }
        if (u.pn < NQM / BM) {
#pragma unroll
            for (int ai = 0; ai < 2; ++ai)
#pragma unroll
                for (int m = 0; m < 4; ++m) { bf16* rowp = H + (size_t)(row0 + ai * HALF + m * 16) * HP + NBF + u.pn * BM + wc * 32 + 8 * fq;
#pragma unroll
                    for (int bj = 0; bj < 2; ++bj) { const i32x4 q0 = acc[ai][bj][m][0], q1 = acc[ai][bj][m][1]; const f32x4 s0 = cs[bj][0] * rs[ai][m], s1 = cs[bj][1] * rs[ai][m];
                        u32x4 w; w.x = pk2((float)q0[0] * s0[0], (float)q0[1] * s0[1]); w.y = pk2((float)q0[2] * s0[2], (float)q0[3] * s0[3]);
                        w.z = pk2((float)q1[0] * s1[0], (float)q1[1] * s1[1]); w.w = pk2((float)q1[2] * s1[2], (float)q1[3] * s1[3]);
                        *(u32x4*)(rowp + bj * HALF) = w; } }
            return;
        }
        const int t28 = u.pn - NQM / BM, up = fq >> 1;
        const int nb = t28 * 64 + wc * 16 + (fq & 1) * 8;
        const size_t rb0 = (size_t)(u.pm * 8 + (t28 >> 2)) * 262144 + (size_t)(wr * 4 + (t28 & 1) * 2 + (wc >> 1)) * 8192 + ((t28 >> 1) & 1) * 512 + (((wc & 1) * 2 + (fq & 1)) * 16 + fr) * 8;
        constexpr bool smp = SMP;
#pragma unroll
        for (int ai = 0; ai < 2; ++ai)
#pragma unroll
            for (int m = 0; m < 4; ++m) {
                float R[4][4];
#pragma unroll
                for (int c = 0; c < 4; ++c) { const i32x4 q = acc[ai][c >> 1][m][c & 1]; const f32x4 sc = cs[c >> 1][c & 1] * (rs[ai][m] * -LOG2E);
                    float a[4];
#pragma unroll
                    for (int k = 0; k < 4; ++k) a[k] = 1.f + ex2(__builtin_amdgcn_fmed3f((float)q[k] * sc[k], -30.f * LOG2E, 30.f * LOG2E));
                    if (smp) { R[0][c] = __builtin_amdgcn_rcpf(a[0]); R[1][c] = __builtin_amdgcn_rcpf(a[1]); R[2][c] = __builtin_amdgcn_rcpf(a[2]); R[3][c] = __builtin_amdgcn_rcpf(a[3]); }
                    else { R[0][c] = a[1] * __builtin_amdgcn_rcpf(a[0]); R[1][c] = a[2] * __builtin_amdgcn_rcpf(a[1]); R[2][c] = a[3] * __builtin_amdgcn_rcpf(a[2]); R[3][c] = __builtin_amdgcn_rcpf(a[3]); } }
                bf16* gp = smp ? H + (size_t)(row0 + ai * HALF + m * 16) * HP + C_GL + nb : RB + rb0 + (ai * 8 + m * 2) * 512;
                const int sstr = smp ? DM : 65536;
#pragma unroll
                for (int p = 0; p < 2; ++p) {
                    unsigned ax = pk2(R[2 * p][0], R[2 * p][1]), ay = pk2(R[2 * p][2], R[2 * p][3]), bx = pk2(R[2 * p + 1][0], R[2 * p + 1][1]), by = pk2(R[2 * p + 1][2], R[2 * p + 1][3]);
                    { auto r = __builtin_amdgcn_permlane32_swap(ax, bx, false, false); ax = r[0]; bx = r[1]; }
                    { auto r = __builtin_amdgcn_permlane32_swap(ay, by, false, false); ay = r[0]; by = r[1]; }
                    if (smp) *(u32x4*)(gp + (2 * p + up) * sstr) = (u32x4){ax, ay, bx, by};
                    else __builtin_nontemporal_store((u32x4){ax, ay, bx, by}, (u32x4*)(gp + (2 * p + up) * sstr)); }
            }
    }
};
struct EpiOut {
    bf16* XN; float* XP; float* ssq;
    static __device__ __forceinline__ bool keep(const Unit&) { return false; }
    __device__ __forceinline__ void operator()(f32x4 (&acc)[2][2][4][2], const Unit& u, int wr, int wc, int fr, int fq) const {
        const int row0 = u.pm * BM + wr * 64 + fr, col0 = u.pn * BM + wc * 32 + 8 * fq;
        if (u.mode == 0) {
#pragma unroll
            for (int ai = 0; ai < 2; ++ai) {
                u32x4 x[4][2];
#pragma unroll
                for (int m = 0; m < 4; ++m)
#pragma unroll
                    for (int bj = 0; bj < 2; ++bj) x[m][bj] = *(const u32x4*)(XN + (size_t)(row0 + ai * HALF + m * 16) * DM + col0 + bj * HALF);
                asm volatile("" ::: "memory");
#pragma unroll
                for (int m = 0; m < 4; ++m) { float q = 0.f;
#pragma unroll
                    for (int bj = 0; bj < 2; ++bj) { const u32x4 xv = x[m][bj];
                        const f32x4 y0 = (f32x4){bflo(xv.x), bfhi(xv.x), bflo(xv.y), bfhi(xv.y)} + acc[ai][bj][m][0], y1 = (f32x4){bflo(xv.z), bfhi(xv.z), bflo(xv.w), bfhi(xv.w)} + acc[ai][bj][m][1];
                        q += ((y0[0] * y0[0] + y0[1] * y0[1]) + (y0[2] * y0[2] + y0[3] * y0[3])) + ((y1[0] * y1[0] + y1[1] * y1[1]) + (y1[2] * y1[2] + y1[3] * y1[3]));
                        u32x4 w; w.x = pk2(y0[0], y0[1]); w.y = pk2(y0[2], y0[3]); w.z = pk2(y1[0], y1[1]); w.w = pk2(y1[2], y1[3]);
                        *(u32x4*)(XN + (size_t)(row0 + ai * HALF + m * 16) * DM + col0 + bj * HALF) = w; }
                    if (ssq) { q += __shfl_xor(q, 16); q += __shfl_xor(q, 32);
                        if (fq == 0) ssq[(size_t)(row0 + ai * HALF + m * 16) * 32 + u.pn * 4 + wc] = q; } }
                asm volatile("" ::: "memory");
            }
        } else {
#pragma unroll
            for (int ai = 0; ai < 2; ++ai)
#pragma unroll
                for (int m = 0; m < 4; ++m) { float* rowp = XP + ((size_t)u.seg * MS + ((size_t)(row0 + ai * HALF + m * 16) - MP)) * DM + col0;
#pragma unroll
                    for (int bj = 0; bj < 2; ++bj) { f32x4* p = (f32x4*)(rowp + bj * HALF); p[0] = acc[ai][bj][m][0]; p[1] = acc[ai][bj][m][1]; } }
        }
    }
};
struct EpiMerge {
    const bf16* RB; bf16* H2;
    static __device__ __forceinline__ bool keep(const Unit& u) { return u.seg < 3; }
    __device__ __forceinline__ void operator()(f32x4 (&acc)[2][2][4][2], const Unit& u, int wr, int wc, int fr, int fq) const {
        const int row0 = u.pm * BM + wr * 64 + fr, col0 = u.pn * BM + wc * 32 + 8 * fq;
        const int seg = u.seg;
        const bf16* rbp = RB + (size_t)(u.pm * 8 + u.pn) * 262144 + seg * 65536 + (wr * 4 + wc) * 8192 + (fq * 16 + fr) * 8;
#define RBL(ai, m, bj) __builtin_nontemporal_load((const u32x4*)(rbp + ((ai) * 8 + (m) * 2 + (bj)) * 512))
#define RBU(ai, m, bj, G0) { const u32x4 g0 = (G0); f32x4 a0 = acc[ai][bj][m][0], a1 = acc[ai][bj][m][1]; \
            a0[0] *= bflo(g0.x); a0[1] *= bfhi(g0.x); a0[2] *= bflo(g0.y); a0[3] *= bfhi(g0.y); a1[0] *= bflo(g0.z); a1[1] *= bfhi(g0.z); a1[2] *= bflo(g0.w); a1[3] *= bfhi(g0.w); \
            acc[ai][bj][m][0] = a0; acc[ai][bj][m][1] = a1; }
        { u32x4 ga[4][2], gb[4][2];
#pragma unroll
          for (int m = 0; m < 4; ++m) { ga[m][0] = RBL(0, m, 0); ga[m][1] = RBL(0, m, 1); }
#pragma unroll
          for (int m = 0; m < 2; ++m) { gb[m][0] = RBL(1, m, 0); gb[m][1] = RBL(1, m, 1); }
          asm volatile("" ::: "memory");
#pragma unroll
          for (int m = 0; m < 4; ++m) { RBU(0, m, 0, ga[m][0]) RBU(0, m, 1, ga[m][1]) }
          asm volatile("" ::: "memory");
#pragma unroll
          for (int m = 2; m < 4; ++m) { gb[m][0] = RBL(1, m, 0); gb[m][1] = RBL(1, m, 1); }
          asm volatile("" ::: "memory");
#pragma unroll
          for (int m = 0; m < 4; ++m) { RBU(1, m, 0, gb[m][0]) RBU(1, m, 1, gb[m][1]) } }
#undef RBL
#undef RBU
        if (seg == 3) {
#pragma unroll
            for (int ai = 0; ai < 2; ++ai)
#pragma unroll
                for (int m = 0; m < 4; ++m)
#pragma unroll
                    for (int bj = 0; bj < 2; ++bj) { const f32x4 a0 = acc[ai][bj][m][0], a1 = acc[ai][bj][m][1];
                        u32x4 w; w.x = pk2(a0[0], a0[1]); w.y = pk2(a0[2], a0[3]); w.z = pk2(a1[0], a1[1]); w.w = pk2(a1[2], a1[3]);
                        *(u32x4*)(H2 + (size_t)(row0 + ai * HALF + m * 16) * DM + col0 + bj * HALF) = w; }
        }
    }
};

struct EpiMergeS {
    const bf16* H; float* MP2;
    static __device__ __forceinline__ bool keep(const Unit&) { return false; }
    __device__ __forceinline__ void operator()(f32x4 (&acc)[2][2][4][2], const Unit& u, int wr, int wc, int fr, int fq) const {
        const int row0 = u.pm * BM + wr * 64 + fr, col0 = u.pn * BM + wc * 32 + 8 * fq;
        const int seg = u.seg;
        u32x4 g[2][4][2];
#pragma unroll
        for (int ai = 0; ai < 2; ++ai)
#pragma unroll
            for (int m = 0; m < 4; ++m)
#pragma unroll
                for (int bj = 0; bj < 2; ++bj) g[ai][m][bj] = *(const u32x4*)(H + (size_t)(row0 + ai * HALF + m * 16) * HP + C_GL + seg * DM + col0 + bj * HALF);
        asm volatile("" ::: "memory");
#pragma unroll
        for (int ai = 0; ai < 2; ++ai)
#pragma unroll
            for (int m = 0; m < 4; ++m) { const size_t row = (size_t)(row0 + ai * HALF + m * 16);
#pragma unroll
                for (int bj = 0; bj < 2; ++bj) { const u32x4 g0 = g[ai][m][bj];
                    const f32x4 a0 = acc[ai][bj][m][0], a1 = acc[ai][bj][m][1];
                    f32x4* p = (f32x4*)(MP2 + ((size_t)seg * MS + (row - MP)) * DM + col0 + bj * HALF);
                    p[0] = (f32x4){a0[0] * bflo(g0.x), a0[1] * bfhi(g0.x), a0[2] * bflo(g0.y), a0[3] * bfhi(g0.y)}; p[1] = (f32x4){a1[0] * bflo(g0.z), a1[1] * bfhi(g0.z), a1[2] * bflo(g0.w), a1[3] * bfhi(g0.w)}; } }
    }
};

template <class Epi, class Sched, bool ALIGN_EPI = false, bool SP2 = false, bool I8 = false>
__device__ __forceinline__ void gemm_phase(PG8_LAS unsigned char* lds, const Gemm g, const Sched& S, const Epi& E) {
    int tid_ = threadIdx.x; asm volatile("" : "+v"(tid_));
    const int tid = tid_, wid = __builtin_amdgcn_readfirstlane(tid >> 6), lane = tid & 63, wr = wid >> 2, wc = wid & 3, fr = lane & 15, fq = lane >> 4;
    const int K = g.K;
    unsigned voffA[2], voffB[2];
#pragma unroll
    for (int i = 0; i < 2; ++i) { int R, C; stage_rc(tid * 16 + i * 8192, R, C); const int Rb = (R & ~31) + perm32(R & 31);
        voffA[i] = (unsigned)(R * K + C * 2); voffB[i] = (unsigned)(Rb * K + C * 2); }
    const size_t kstep = (size_t)(BK * 2);
    const size_t hstep = (size_t)HALF * K;
    const size_t tstep = 2 * hstep;
    const unsigned ldsw = (unsigned)wid * 1024u;
    const int aoff = lds_byte(wr * 64 + fr, fq * 8), boff = lds_byte(wc * 32 + fr, fq * 8);
#define PG8_SA(b, h) (((b) * 2 + (h)) * HTB)
#define PG8_SB(b, h) ((4 + (b) * 2 + (h)) * HTB)
#define PG8_STAGE(bufoff, gbase, voff) do { _Pragma("unroll") for (int _i = 0; _i < 2; ++_i) \
        __builtin_amdgcn_global_load_lds((const unsigned*)((const char*)(gbase) + (voff)[_i]), (PG8_LAS unsigned*)(lds + (bufoff) + ldsw + _i * 8192), 16, 0, 0); } while (0)
#define PG8_LDA(dst, b, h) do { _Pragma("unroll") for (int m = 0; m < 4; ++m) _Pragma("unroll") for (int k = 0; k < 2; ++k) dst[m][k] = *(const PG8_LAS bf16x8*)(lds + PG8_SA(b, h) + aoff + m * 2048 + k * 1024); } while (0)
#define PG8_LDB(dst, b, h) do { _Pragma("unroll") for (int n = 0; n < 2; ++n) _Pragma("unroll") for (int k = 0; k < 2; ++k) dst[n][k] = *(const PG8_LAS bf16x8*)(lds + PG8_SB(b, h) + boff + n * 2048 + k * 1024); } while (0)
#define PG8_MMA(ai, bj, At, Bt) do { __builtin_amdgcn_s_setprio(1); _Pragma("unroll") for (int m = 0; m < 4; ++m) _Pragma("unroll") for (int n = 0; n < 2; ++n) _Pragma("unroll") for (int k = 0; k < 2; ++k) \
        { if constexpr (I8) acc[ai][bj][m][n] = __builtin_bit_cast(acc4, __builtin_amdgcn_mfma_i32_16x16x64_i8(__builtin_bit_cast(i32x4, Bt[n][k]), __builtin_bit_cast(i32x4, At[m][k]), __builtin_bit_cast(i32x4, acc[ai][bj][m][n]), 0, 0, 0)); \
          else acc[ai][bj][m][n] = __builtin_bit_cast(acc4, __builtin_amdgcn_mfma_f32_16x16x32_bf16(Bt[n][k], At[m][k], __builtin_bit_cast(f32x4, acc[ai][bj][m][n]), 0, 0, 0)); } __builtin_amdgcn_s_setprio(0); } while (0)
#define PG8_WAIT_V(n) asm volatile("s_waitcnt vmcnt(" #n ")" ::: "memory")
#define PG8_WAIT_L(n) asm volatile("s_waitcnt lgkmcnt(" #n ")" ::: "memory")
#define PG8_BAR __builtin_amdgcn_s_barrier()
#define PG8_SCHED __builtin_amdgcn_sched_barrier(0)
    Unit cur, nxt; int ui = 0;
    if (!S.next(0, cur)) return;
    typedef typename std::conditional<I8, i32x4, f32x4>::type acc4;
    acc4 acc[2][2][4][2];
#pragma unroll
    for (int a = 0; a < 2; ++a)
#pragma unroll
        for (int b = 0; b < 2; ++b)
#pragma unroll
            for (int m = 0; m < 4; ++m)
#pragma unroll
                for (int n = 0; n < 2; ++n) acc[a][b][m][n] = (acc4){0, 0, 0, 0};
    bf16x8 At[4][2], B0[2][2], B1[2][2];
    const char* cA = (const char*)g.A + (size_t)cur.pm * tstep + (size_t)cur.seg * g.segb; const char* cB = (const char*)g.Bt + (size_t)cur.pn * tstep + (size_t)cur.seg * g.segb;
    if constexpr (SP2) {
        PG8_STAGE(PG8_SB(0, 0), cB, voffB); PG8_STAGE(PG8_SB(0, 1), cB + hstep, voffB); PG8_STAGE(PG8_SA(0, 0), cA, voffA); PG8_STAGE(PG8_SA(0, 1), cA + hstep, voffA);
        if (wr == 1) PG8_BAR;
        PG8_WAIT_V(2); PG8_BAR;
        PG8_STAGE(PG8_SB(1, 0), cB + kstep, voffB); PG8_STAGE(PG8_SA(1, 0), cA + kstep, voffA); PG8_STAGE(PG8_SB(1, 1), cB + hstep + kstep, voffB);
        PG8_WAIT_V(6); PG8_BAR;
    } else {
        PG8_STAGE(PG8_SB(0, 0), cB, voffB); PG8_STAGE(PG8_SA(0, 0), cA, voffA); PG8_STAGE(PG8_SB(0, 1), cB + hstep, voffB); PG8_STAGE(PG8_SA(0, 1), cA + hstep, voffA);
        if (wr == 1) PG8_BAR;
        PG8_WAIT_V(4); PG8_BAR;
        PG8_STAGE(PG8_SB(1, 0), cB + kstep, voffB); PG8_STAGE(PG8_SA(1, 0), cA + kstep, voffA); PG8_STAGE(PG8_SB(1, 1), cB + hstep + kstep, voffB);
        PG8_WAIT_V(6); PG8_BAR;
    }
    for (;;) {
        const bool has_next = S.next(ui + 1, nxt);
        const char* nA = has_next ? (const char*)g.A + (size_t)nxt.pm * tstep + (size_t)nxt.seg * g.segb : cA;
        const char* nB = has_next ? (const char*)g.Bt + (size_t)nxt.pn * tstep + (size_t)nxt.seg * g.segb : cB;
        const int nt = cur.nt;
        for (int t = 0; t < nt; t += 2) {
            const bool last = (t == nt - 2);
            const char* a1 = cA + (size_t)(t + 1) * kstep;
            const char* a2 = last ? nA : cA + (size_t)(t + 2) * kstep; const char* b2 = last ? nB : cB + (size_t)(t + 2) * kstep;
            const char* a3 = a2 + kstep; const char* b3 = b2 + kstep;
            if constexpr (SP2) {
            PG8_LDB(B0, 0, 0); PG8_LDB(B1, 0, 1); PG8_SCHED; PG8_LDA(At, 0, 0); PG8_STAGE(PG8_SA(1, 1), a1 + hstep, voffA);
            PG8_WAIT_V(8); PG8_WAIT_L(0); PG8_BAR; PG8_MMA(0, 0, At, B0); PG8_MMA(0, 1, At, B1); PG8_BAR; PG8_SCHED;
            PG8_LDA(At, 0, 1); PG8_STAGE(PG8_SB(0, 0), b2, voffB); PG8_STAGE(PG8_SB(0, 1), b2 + hstep, voffB); PG8_STAGE(PG8_SA(0, 0), a2, voffA);
            PG8_WAIT_V(8); PG8_WAIT_L(0); PG8_BAR; PG8_MMA(1, 0, At, B0); PG8_MMA(1, 1, At, B1); PG8_BAR; PG8_SCHED;
            PG8_LDB(B0, 1, 0); PG8_LDB(B1, 1, 1); PG8_SCHED; PG8_LDA(At, 1, 0); PG8_STAGE(PG8_SA(0, 1), a2 + hstep, voffA);
            PG8_WAIT_V(8); PG8_WAIT_L(0); PG8_BAR; PG8_MMA(0, 0, At, B0); PG8_MMA(0, 1, At, B1); PG8_BAR; PG8_SCHED;
            PG8_LDA(At, 1, 1); PG8_STAGE(PG8_SB(1, 0), b3, voffB); PG8_STAGE(PG8_SB(1, 1), b3 + hstep, voffB); PG8_STAGE(PG8_SA(1, 0), a3, voffA);
            PG8_WAIT_V(8); PG8_WAIT_L(0); PG8_BAR; PG8_MMA(1, 0, At, B0); PG8_MMA(1, 1, At, B1); PG8_BAR; PG8_SCHED;
            } else {
            PG8_LDB(B0, 0, 0); PG8_SCHED; PG8_LDA(At, 0, 0); PG8_STAGE(PG8_SA(1, 1), a1 + hstep, voffA);
            PG8_WAIT_L(8); PG8_BAR; PG8_WAIT_L(0); PG8_MMA(0, 0, At, B0); PG8_BAR; PG8_SCHED;
            PG8_LDB(B1, 0, 1); PG8_STAGE(PG8_SB(0, 0), b2, voffB);
            PG8_BAR; PG8_WAIT_L(0); PG8_MMA(0, 1, At, B1); PG8_BAR;
            PG8_LDA(At, 0, 1); PG8_STAGE(PG8_SA(0, 0), a2, voffA);
            PG8_BAR; PG8_WAIT_L(0); PG8_MMA(1, 0, At, B0); PG8_BAR; PG8_SCHED;
            PG8_STAGE(PG8_SB(0, 1), b2 + hstep, voffB);
            PG8_WAIT_V(6); PG8_BAR; PG8_MMA(1, 1, At, B1); PG8_BAR;
            PG8_LDB(B0, 1, 0); PG8_SCHED; PG8_LDA(At, 1, 0); PG8_STAGE(PG8_SA(0, 1), a2 + hstep, voffA);
            PG8_WAIT_L(8); PG8_BAR; PG8_WAIT_L(0); PG8_MMA(0, 0, At, B0); PG8_BAR; PG8_SCHED;
            PG8_LDB(B1, 1, 1); PG8_STAGE(PG8_SB(1, 0), b3, voffB);
            PG8_BAR; PG8_WAIT_L(0); PG8_MMA(0, 1, At, B1); PG8_BAR;
            PG8_LDA(At, 1, 1); PG8_STAGE(PG8_SA(1, 0), a3, voffA);
            PG8_BAR; PG8_WAIT_L(0); PG8_MMA(1, 0, At, B0); PG8_BAR; PG8_SCHED;
            PG8_STAGE(PG8_SB(1, 1), b3 + hstep, voffB);
            PG8_WAIT_V(6); PG8_BAR; PG8_MMA(1, 1, At, B1); PG8_BAR;
            }
        }
        if constexpr (ALIGN_EPI) { if (wr == 0) PG8_BAR; }
        { Unit eu = cur; { int a_ = cur.pm, b_ = cur.pn, c_ = cur.seg; asm volatile("" : "+v"(a_), "+v"(b_), "+v"(c_)); eu.pm = __builtin_amdgcn_readfirstlane(a_); eu.pn = __builtin_amdgcn_readfirstlane(b_); eu.seg = __builtin_amdgcn_readfirstlane(c_); }
          E(acc, eu, wr, wc, fr, fq); }
        if (!has_next) break;
        if (!Epi::keep(cur)) {
#pragma unroll
        for (int a = 0; a < 2; ++a)
#pragma unroll
            for (int b = 0; b < 2; ++b)
#pragma unroll
                for (int m = 0; m < 4; ++m)
#pragma unroll
                    for (int n = 0; n < 2; ++n) acc[a][b][m][n] = (acc4){0, 0, 0, 0};
        }
        cur = nxt; cA = nA; cB = nB; ++ui;
        if constexpr (ALIGN_EPI) { if (wr == 1) PG8_BAR; }
    }
    PG8_WAIT_V(0);
    if constexpr (!ALIGN_EPI) { if (wr == 0) PG8_BAR; }
    PG8_BAR;
#undef PG8_SA
#undef PG8_SB
#undef PG8_STAGE
#undef PG8_LDA
#undef PG8_LDB
#undef PG8_MMA
#undef PG8_WAIT_V
#undef PG8_WAIT_L
#undef PG8_BAR
#undef PG8_SCHED
}
}

#define XB_TMO      128
#define XB_XCNT(j)  (256  + 64 * (j))
#define XB_XSUB(j)  (1280 + 64 * (j))
#define XB_XGEN(j)  (2304 + 64 * (j))
#define XB_TOP      3328
#define XB_TOPGEN   3392
#define XCD_BAR_WORDS 3456
#define XB_SPIN_CAP (1u << 18)
__device__ __forceinline__ unsigned xb_ld(unsigned* p)              { return __hip_atomic_load(p, __ATOMIC_RELAXED, __HIP_MEMORY_SCOPE_AGENT); }
__device__ __forceinline__ unsigned xb_add(unsigned* p, unsigned v) { return __hip_atomic_fetch_add(p, v, __ATOMIC_RELAXED, __HIP_MEMORY_SCOPE_AGENT); }
__device__ __forceinline__ unsigned xb_xcc_id() { return (unsigned)__builtin_amdgcn_s_getreg((3 << 11) | 20) & 0xFu; }
#define XB_SPIN(cond, bar) do { unsigned _sp = 0; while (cond) { __builtin_amdgcn_s_sleep(1); \
    if ((++_sp & 255u) == 0u) { if (xb_ld(&(bar)[XB_TMO])) break; if (_sp > XB_SPIN_CAP) { atomicAdd(&(bar)[XB_TMO], 1u); break; } } } } while (0)
struct XcdBarrier { unsigned* bar; unsigned x; volatile LAS unsigned* st; };
__device__ __forceinline__ XcdBarrier xcd_barrier_post(unsigned* bar, volatile LAS unsigned* st) {
    XcdBarrier b; b.bar = bar; b.x = xb_xcc_id(); b.st = st;
    if (threadIdx.x == 0) (void)xb_add(&bar[XB_XCNT(b.x)], 1u);
    return b;
}
__device__ __forceinline__ void xcd_barrier_complete(unsigned* bar, unsigned x, unsigned& nloc, unsigned& nx) {
    const unsigned G = gridDim.x * gridDim.y * gridDim.z;
    unsigned sum, cnt, mine, sp = 0u;
    for (;;) {
        sum = 0u; cnt = 0u; mine = 0u;
#pragma unroll
        for (unsigned j = 0; j < 16; ++j) { const unsigned c = xb_ld(&bar[XB_XCNT(j)]); sum += c; cnt += (c > 0u) ? 1u : 0u; mine = (j == x) ? c : mine; }
        if (sum == G) break;
        __builtin_amdgcn_s_sleep(1);
        if ((++sp & 255u) == 0u) { if (xb_ld(&bar[XB_TMO])) break; if (sp > XB_SPIN_CAP) { atomicAdd(&bar[XB_TMO], 1u); break; } }
    }
    nloc = mine > 0u ? mine : 1u; nx = cnt > 0u ? cnt : 1u;
}
__device__ __forceinline__ void xcd_barrier(const XcdBarrier& b) {
    asm volatile("s_waitcnt vmcnt(0)" ::: "memory");
    __syncthreads();
    if (threadIdx.x == 0) {
        unsigned* bar = b.bar;
        __builtin_amdgcn_s_waitcnt(0);
        unsigned nloc = b.st[0], nx = b.st[1];
        if (nloc == 0u) { xcd_barrier_complete(bar, b.x, nloc, nx); b.st[0] = nloc; b.st[1] = nx; }
        const unsigned old = xb_add(&bar[XB_XSUB(b.x)], 1u);
        const unsigned gen = old / nloc;
        if (old + 1u == (gen + 1u) * nloc) {
            __builtin_amdgcn_fence(__ATOMIC_RELEASE, "agent");
            asm volatile("s_waitcnt vmcnt(0)" ::: "memory");
            const unsigned og = xb_add(&bar[XB_TOP], 1u);
            const unsigned tg = og / nx;
            if (og + 1u == (tg + 1u) * nx) xb_add(&bar[XB_TOPGEN], 1u);
            else XB_SPIN(xb_ld(&bar[XB_TOPGEN]) == tg, bar);
            __builtin_amdgcn_fence(__ATOMIC_ACQUIRE, "agent");
            xb_add(&bar[XB_XGEN(b.x)], 1u);
            asm volatile("s_waitcnt vmcnt(0)" ::: "memory");
        } else {
            XB_SPIN(xb_ld(&bar[XB_XGEN(b.x)]) == gen, bar);
            __builtin_amdgcn_fence(__ATOMIC_ACQUIRE, "agent");
            asm volatile("s_waitcnt vmcnt(0)" ::: "memory");
        }
    }
    __syncthreads();
}

template <bool GAIN> __device__ __forceinline__ void transpose_item(const float* W, int ldw, int k0, int n0, bf16* WT, int ldt, int kofs, LAS float* scr, int lane, const float* kgain = nullptr, int ndst = -1) {
    if (ndst < 0) ndst = n0;
    float wv[32];
#pragma unroll
    for (int i = 0; i < 32; ++i) { const int kk = 2 * i + (lane >> 5); wv[i] = __builtin_nontemporal_load(W + (size_t)(k0 + kk) * ldw + n0 + (lane & 31)); }
#pragma unroll
    for (int i = 0; i < 32; ++i) { const int kk = 2 * i + (lane >> 5); scr[kk * 33 + (lane & 31)] = GAIN ? wv[i] * kgain[k0 + kk] : wv[i]; }
    asm volatile("s_waitcnt lgkmcnt(0)" ::: "memory");
    const int c = lane & 7;
#pragma unroll
    for (int j = 0; j < 4; ++j) { const int n = (lane >> 3) + 8 * j; const LAS float* s = scr + (8 * c) * 33 + n;
        u32x4 o; o.x = pk2(s[0 * 33], s[1 * 33]); o.y = pk2(s[2 * 33], s[3 * 33]); o.z = pk2(s[4 * 33], s[5 * 33]); o.w = pk2(s[6 * 33], s[7 * 33]);
        const int nr = ndst + n;
        *(u32x4*)(WT + (size_t)nr * ldt + kofs + k0 + 8 * c) = o; }
    asm volatile("s_waitcnt lgkmcnt(0)" ::: "memory");
}
__device__ __forceinline__ unsigned pack_i8x4(float a, float b, float c, float d) {
    const int ia = (int)rintf(a), ib = (int)rintf(b), ic = (int)rintf(c), id = (int)rintf(d);
    return (unsigned)(ia & 255) | ((unsigned)(ib & 255) << 8) | ((unsigned)(ic & 255) << 16) | ((unsigned)id << 24);
}
__device__ __forceinline__ void colmax_item(const float* W, int ldw, int k0, int n0, const float* kgain, unsigned* cmax, int lane) {
    float m = 0.f;
#pragma unroll 8
    for (int i = 0; i < 32; ++i) { const int kk = 2 * i + (lane >> 5); m = fmaxf(m, fabsf(W[(size_t)(k0 + kk) * ldw + n0 + (lane & 31)] * kgain[k0 + kk])); }
    m = fmaxf(m, __shfl_xor(m, 32));
    if (lane < 32) __hip_atomic_fetch_max(cmax + lane, __builtin_bit_cast(unsigned, m), __ATOMIC_RELAXED, __HIP_MEMORY_SCOPE_AGENT);
}
__device__ __forceinline__ void transq_item(const float* W, int ldw, int k0, int n0, signed char* WQ, float* SW, const unsigned* cmax, const float* kgain, LAS float* scr, int lane, bool gate, int base) {
#pragma unroll 8
    for (int i = 0; i < 32; ++i) { const int kk = 2 * i + (lane >> 5); scr[kk * 33 + (lane & 31)] = W[(size_t)(k0 + kk) * ldw + n0 + (lane & 31)] * kgain[k0 + kk]; }
    asm volatile("s_waitcnt lgkmcnt(0)" ::: "memory");
    const int c = lane & 7;
#pragma unroll
    for (int j = 0; j < 4; ++j) { const int n = (lane >> 3) + 8 * j; const LAS float* sp = scr + (8 * c) * 33 + n;
        const int gc = base + n, i = gc >> 11, ch = gc & 2047, r = ch & 63;
        const int pos = gate ? NQM + (ch >> 6) * 256 + ((r >> 1) & 1) * 128 + (r >> 4) * 32 + (((r >> 3) & 1) + 2 * ((r >> 2) & 1)) * 8 + (r & 1) * 4 + i : base + n;
        const float cm = __builtin_bit_cast(float, cmax[gate ? NQM + gc : base + n]), inv = cm > 0.f ? 127.f / cm : 0.f;
        u32x2 o; o.x = pack_i8x4(sp[0 * 33] * inv, sp[1 * 33] * inv, sp[2 * 33] * inv, sp[3 * 33] * inv); o.y = pack_i8x4(sp[4 * 33] * inv, sp[5 * 33] * inv, sp[6 * 33] * inv, sp[7 * 33] * inv);
        *(u32x2*)(WQ + (size_t)pos * DM + k0 + 8 * c) = o;
        if (k0 == 0 && c == 0) SW[pos] = cm * (1.f / 127.f); }
    asm volatile("s_waitcnt lgkmcnt(0)" ::: "memory");
}
__device__ __forceinline__ void quantw_item(const float* W, int n0, const float* kgain, signed char* WQ, float* SW, bool gate, int base, LAS float* red, int tid) {
    const int lane = tid & 63, wave = tid >> 6, n = lane & 31, kb = wave * 256 + (lane >> 5) * 128;
    const unsigned off = (unsigned)(kb * HP + n0 + n);
    typedef __fp16 hf2 __attribute__((ext_vector_type(2)));
    unsigned pk[64]; float m = 0.f;
#pragma unroll
    for (int c = 0; c < 4; ++c) {
        float v[32];
#pragma unroll
        for (int i = 0; i < 32; ++i) v[i] = __builtin_nontemporal_load(W + (off + (unsigned)((32 * c + i) * HP)));
#pragma unroll
        for (int i = 0; i < 32; i += 4) { const f32x4 g = *(const f32x4*)(kgain + kb + 32 * c + i);
            v[i] *= g.x; v[i + 1] *= g.y; v[i + 2] *= g.z; v[i + 3] *= g.w;
            m = fmaxf(fmaxf(m, fmaxf(fabsf(v[i]), fabsf(v[i + 1]))), fmaxf(fabsf(v[i + 2]), fabsf(v[i + 3])));
            pk[16 * c + (i >> 1)] = __builtin_bit_cast(unsigned, __builtin_amdgcn_cvt_pkrtz(v[i], v[i + 1]));
            pk[16 * c + (i >> 1) + 1] = __builtin_bit_cast(unsigned, __builtin_amdgcn_cvt_pkrtz(v[i + 2], v[i + 3])); }
    }
    m = fmaxf(m, __shfl_xor(m, 32));
    if (lane < 32) red[wave * 32 + lane] = m;
    __syncthreads();
    float cm = red[n];
#pragma unroll
    for (int w = 1; w < 8; ++w) cm = fmaxf(cm, red[w * 32 + n]);
    const float inv = cm > 0.f ? 127.f / cm : 0.f;
    const int gc = base + n, gi = gc >> 11, ch = gc & 2047, r = ch & 63;
    const int pos = gate ? NQM + (ch >> 6) * 256 + ((r >> 1) & 1) * 128 + (r >> 4) * 32 + (((r >> 3) & 1) + 2 * ((r >> 2) & 1)) * 8 + (r & 1) * 4 + gi : base + n;
    signed char* dst = WQ + (size_t)pos * DM + kb;
#pragma unroll
    for (int q = 0; q < 8; ++q) { u32x4 o;
#pragma unroll
        for (int e = 0; e < 4; ++e) { const hf2 h0 = __builtin_bit_cast(hf2, pk[8 * q + 2 * e]), h1 = __builtin_bit_cast(hf2, pk[8 * q + 2 * e + 1]);
            o[e] = pack_i8x4((float)h0[0] * inv, (float)h0[1] * inv, (float)h1[0] * inv, (float)h1[1] * inv); }
        *(u32x4*)(dst + 16 * q) = o; }
    if (tid < 32) SW[pos] = cm * (1.f / 127.f);
    __syncthreads();
}
__device__ __forceinline__ void norm_row(const float* src, float* xcopy, bf16* xn, float* yout, const float* gain, int lane, const float* part = nullptr, float* ssq_out = nullptr, signed char* xq = nullptr, float* rsc_out = nullptr) {
    const f32x4* xr = (const f32x4*)src + lane;
    f32x4 v[8]; float s = 0.f;
#pragma unroll
    for (int j = 0; j < 8; ++j) v[j] = __builtin_nontemporal_load(xr + 64 * j);
    if (part) {
#pragma unroll
        for (int q = 0; q < 8; ++q) { const f32x4* pr = (const f32x4*)(part + (size_t)q * MS * DM) + lane;
#pragma unroll
            for (int j = 0; j < 8; ++j) v[j] += pr[64 * j]; }
    }
#pragma unroll
    for (int j = 0; j < 8; ++j) s += (v[j].x * v[j].x + v[j].y * v[j].y) + (v[j].z * v[j].z + v[j].w * v[j].w);
    const float tot = wave_sum(s);
    const float rstd = ssq_out ? 1.f : __builtin_amdgcn_rsqf(tot * (1.f / DM) + NORM_EPS);
    if (ssq_out && lane == 0) *ssq_out = tot;
    if (xq) {
        float am = 0.f;
#pragma unroll
        for (int j = 0; j < 8; ++j) am = fmaxf(fmaxf(am, fmaxf(fabsf(v[j].x), fabsf(v[j].y))), fmaxf(fabsf(v[j].z), fabsf(v[j].w)));
        am = wave_max(am);
        const float inv = am > 0.f ? 127.f / am : 0.f;
        if (lane == 0) *rsc_out = __builtin_amdgcn_rsqf(tot * (1.f / DM) + NORM_EPS) * am * (1.f / 127.f);
#pragma unroll
        for (int j = 0; j < 8; ++j) ((unsigned*)xq + lane)[64 * j] = pack_i8x4(v[j].x * inv, v[j].y * inv, v[j].z * inv, v[j].w * inv);
    }
    if (xcopy) {
#pragma unroll
        for (int j = 0; j < 8; ++j) ((f32x4*)xcopy + lane)[64 * j] = v[j];
    }
    const f32x4* gr = (const f32x4*)gain + lane;
#pragma unroll
    for (int j = 0; j < 8; ++j) { const f32x4 y = ssq_out ? v[j] : v[j] * rstd * gr[64 * j];
        if (xn) { u32x2 w; w.x = pk2(y.x, y.y); w.y = pk2(y.z, y.w); ((u32x2*)xn + lane)[64 * j] = w; }
        else ((f32x4*)yout + lane)[64 * j] = y; }
}

__device__ __forceinline__ void norm_row_bf(const bf16* src, bf16* xn, float* yout, const float* gain, int lane, const float* part, float* ssq_out, signed char* xq = nullptr, float* rsc_out = nullptr) {
    f32x4 v[4][2]; float s = 0.f;
#pragma unroll
    for (int j = 0; j < 4; ++j) { const u32x4 t = *(const u32x4*)(src + lane * 8 + 512 * j);
        v[j][0] = (f32x4){bflo(t.x), bfhi(t.x), bflo(t.y), bfhi(t.y)}; v[j][1] = (f32x4){bflo(t.z), bfhi(t.z), bflo(t.w), bfhi(t.w)}; }
    if (part) {
#pragma unroll
        for (int qh = 0; qh < 2; ++qh) { f32x4 pv[4][4][2];
#pragma unroll
            for (int q = 0; q < 4; ++q) { const float* pr = part + (size_t)(qh * 4 + q) * MS * DM + lane * 8;
#pragma unroll
                for (int j = 0; j < 4; ++j) { pv[q][j][0] = *(const f32x4*)(pr + 512 * j); pv[q][j][1] = *(const f32x4*)(pr + 512 * j + 4); } }
            asm volatile("" ::: "memory");
#pragma unroll
            for (int q = 0; q < 4; ++q)
#pragma unroll
                for (int j = 0; j < 4; ++j) { v[j][0] += pv[q][j][0]; v[j][1] += pv[q][j][1]; }
            asm volatile("" ::: "memory"); }
    }
#pragma unroll
    for (int j = 0; j < 4; ++j)
#pragma unroll
        for (int hf = 0; hf < 2; ++hf) { const f32x4 a = v[j][hf]; s += (a.x * a.x + a.y * a.y) + (a.z * a.z + a.w * a.w); }
    const float tot = wave_sum(s);
    if (ssq_out) {
        if (lane == 0) *ssq_out = tot;
        if (xq) {
            float am = 0.f;
#pragma unroll
            for (int j = 0; j < 4; ++j)
#pragma unroll
                for (int hf = 0; hf < 2; ++hf) { const f32x4 a = v[j][hf]; am = fmaxf(fmaxf(am, fmaxf(fabsf(a.x), fabsf(a.y))), fmaxf(fabsf(a.z), fabsf(a.w))); }
            am = wave_max(am);
            const float inv = am > 0.f ? 127.f / am : 0.f;
            if (lane == 0) *rsc_out = __builtin_amdgcn_rsqf(tot * (1.f / DM) + NORM_EPS) * am * (1.f / 127.f);
#pragma unroll
            for (int j = 0; j < 4; ++j) *(u32x2*)(xq + lane * 8 + 512 * j) = (u32x2){pack_i8x4(v[j][0].x * inv, v[j][0].y * inv, v[j][0].z * inv, v[j][0].w * inv), pack_i8x4(v[j][1].x * inv, v[j][1].y * inv, v[j][1].z * inv, v[j][1].w * inv)};
        }
        if (xn) {
#pragma unroll
        for (int j = 0; j < 4; ++j) { u32x4 w; w.x = pk2(v[j][0].x, v[j][0].y); w.y = pk2(v[j][0].z, v[j][0].w); w.z = pk2(v[j][1].x, v[j][1].y); w.w = pk2(v[j][1].z, v[j][1].w);
            *(u32x4*)(xn + lane * 8 + 512 * j) = w; } }
    } else {
        const float rstd = __builtin_amdgcn_rsqf(tot * (1.f / DM) + NORM_EPS);
#pragma unroll
        for (int j = 0; j < 4; ++j) { const float* gp = gain + lane * 8 + 512 * j; v[j][0] = v[j][0] * rstd * *(const f32x4*)gp; v[j][1] = v[j][1] * rstd * *(const f32x4*)(gp + 4); }
        asm volatile("" ::: "memory");
#pragma unroll
        for (int j = 0; j < 4; ++j) { float* op = yout + lane * 8 + 512 * j; *(f32x4*)op = v[j][0]; *(f32x4*)(op + 4) = v[j][1]; }
    }
}

struct MixArgs {
    const bf16* H; bf16* BR; float* out; float* U; bf16* SB;
    const float *state_ret, *state_conv, *cache_k, *cache_v, *conv_w, *ln_g, *ln_b, *gws, *gbs, *relb;
    int l;
};

__device__ __forceinline__ void attn_prompt_unit(const MixArgs& A, int unit, LAS uchar* lds, int tid, int lane, int wave) {
    const int qg = unit & 7, h = (unit >> 3) & 7, b = unit >> 6;
    LAS float* tb = (LAS float*)(lds + 36864);
    const bf16* H = A.H;
    __syncthreads();
    for (int i = tid; i < 257; i += NTHR) tb[i] = A.relb[h * 257 + i] * LOG2E;
    const int c = 4 * qg + (wave >> 1);
    const int qi = (wave & 1) * 32 + (lane & 31), hh = lane >> 5;
    const size_t qrow = (size_t)b * SEQ + c * 64 + qi;
    bf16x8 qf[4];
#pragma unroll
    for (int ks = 0; ks < 4; ++ks) { u32x4 t = *(const u32x4*)(H + qrow * HP + C_AQ + h * 64 + ks * 16 + 8 * hh);
        const float c2 = 0.125f * LOG2E;
        t.x = pk2(bflo(t.x) * c2, bfhi(t.x) * c2); t.y = pk2(bflo(t.y) * c2, bfhi(t.y) * c2); t.z = pk2(bflo(t.z) * c2, bfhi(t.z) * c2); t.w = pk2(bflo(t.w) * c2, bfhi(t.w) * c2);
        qf[ks] = __builtin_bit_cast(bf16x8, t); }
    f32x16 o0 = {}, o1 = {};
    float mrun = -1e30f, lsum = 0.f;
    const int kt_lo = (4 * qg - 8) > 0 ? (4 * qg - 8) : 0, kt_hi = 4 * qg + 3;
    const int skey = tid >> 3, spart = tid & 7;
    u32x4 kreg, vreg, kreg2 = {0u, 0u, 0u, 0u}, vreg2 = {0u, 0u, 0u, 0u};
    { const size_t r0 = (size_t)b * SEQ + kt_lo * 64;
      kreg = *(const u32x4*)(H + (r0 + skey) * HP + C_AK + h * 64 + spart * 8);
      vreg = *(const u32x4*)(H + (r0 + skey) * HP + C_AV + h * 64 + spart * 8);
      if (kt_lo < kt_hi) { kreg2 = *(const u32x4*)(H + (r0 + 64 + skey) * HP + C_AK + h * 64 + spart * 8); vreg2 = *(const u32x4*)(H + (r0 + 64 + skey) * HP + C_AV + h * 64 + spart * 8); } }
#define ATT_STAGE(bufp) do { LAS uchar* Ks_ = (bufp); LAS uchar* Vt_ = (bufp) + 9216; \
        *(LAS u32x4*)(Ks_ + skey * 144 + spart * 16) = kreg; \
        LAS uchar* vp = Vt_ + (spart * 8) * 144 + (skey ^ (spart << 3)) * 2;          \
        *(LAS bf16*)(vp + 0 * 144) = (bf16)(vreg.x & 0xffffu); *(LAS bf16*)(vp + 1 * 144) = (bf16)(vreg.x >> 16); \
        *(LAS bf16*)(vp + 2 * 144) = (bf16)(vreg.y & 0xffffu); *(LAS bf16*)(vp + 3 * 144) = (bf16)(vreg.y >> 16); \
        *(LAS bf16*)(vp + 4 * 144) = (bf16)(vreg.z & 0xffffu); *(LAS bf16*)(vp + 5 * 144) = (bf16)(vreg.z >> 16); \
        *(LAS bf16*)(vp + 6 * 144) = (bf16)(vreg.w & 0xffffu); *(LAS bf16*)(vp + 7 * 144) = (bf16)(vreg.w >> 16); } while (0)
    ATT_STAGE(lds);
    kreg = kreg2; vreg = vreg2;
    if (kt_lo + 2 <= kt_hi) { const size_t r0 = (size_t)b * SEQ + (kt_lo + 2) * 64;
        kreg2 = *(const u32x4*)(H + (r0 + skey) * HP + C_AK + h * 64 + spart * 8);
        vreg2 = *(const u32x4*)(H + (r0 + skey) * HP + C_AV + h * 64 + spart * 8); }
    __syncthreads();
    for (int kt = kt_lo; kt <= kt_hi; ++kt) {
        LAS uchar* Ks = lds + ((kt - kt_lo) & 1) * 18432; LAS uchar* Vt = Ks + 9216;
        if (kt < kt_hi) {
            ATT_STAGE(lds + ((kt + 1 - kt_lo) & 1) * 18432);
            kreg = kreg2; vreg = vreg2;
            if (kt + 3 <= kt_hi) { const size_t r0 = (size_t)b * SEQ + (kt + 3) * 64;
                kreg2 = *(const u32x4*)(H + (r0 + skey) * HP + C_AK + h * 64 + spart * 8);
                vreg2 = *(const u32x4*)(H + (r0 + skey) * HP + C_AV + h * 64 + spart * 8); } }
        if (kt >= c - 8 && kt <= c) {
            f32x16 s0 = {}, s1 = {};
#pragma unroll
            for (int ks = 0; ks < 4; ++ks) {
                const bf16x8 a0 = ldfrag(Ks, 144, 0, ks * 16, lane), a1 = ldfrag(Ks, 144, 32, ks * 16, lane);
                s0 = MFMA32(a0, qf[ks], s0); s1 = MFMA32(a1, qf[ks], s1);
            }
            const int dc = c - kt;
            float bb = 0.f;
            if (dc >= 3) bb = tb[256];
            else {
                const int base = dc * 64 + qi - 4 * hh + 128;
#pragma unroll
                for (int r = 0; r < 16; ++r) { const int ki = (r & 3) + 8 * (r >> 2);
                    int i0 = base - ki, i1 = base - ki - 32;
                    i0 = i0 < 0 ? 0 : (i0 > 256 ? 256 : i0); i1 = i1 < 0 ? 0 : (i1 > 256 ? 256 : i1);
                    s0[r] += tb[i0]; s1[r] += tb[i1]; }
            }
            float mt = s0[0];
#pragma unroll
            for (int r = 1; r < 16; ++r) mt = fmaxf(mt, s0[r]);
#pragma unroll
            for (int r = 0; r < 16; ++r) mt = fmaxf(mt, s1[r]);
            mt = fmaxf(mt, __shfl_xor(mt, 32)) + bb;
            const float mnew = fmaxf(mrun, mt), alpha = ex2(mrun - mnew), moff = mnew - bb;
            float ps = 0.f;
#pragma unroll
            for (int r = 0; r < 16; ++r) { s0[r] = ex2(s0[r] - moff); s1[r] = ex2(s1[r] - moff); ps += s0[r] + s1[r]; }
            lsum = lsum * alpha + ps; mrun = mnew;
            if (__any(alpha != 1.f)) {
#pragma unroll
                for (int r = 0; r < 16; ++r) { o0[r] *= alpha; o1[r] *= alpha; } }
#pragma unroll
            for (int s2 = 0; s2 < 2; ++s2) {
                const bf16x8 p0 = acc_frag(s0, s2), p1 = acc_frag(s1, s2);
                o0 = MFMA32(ldfrag_perm_sw<3>(Vt, 144, 0, 16 * s2, lane), p0, o0);
                o1 = MFMA32(ldfrag_perm_sw<3>(Vt, 144, 32, 16 * s2, lane), p0, o1);
                o0 = MFMA32(ldfrag_perm_sw<3>(Vt, 144, 0, 32 + 16 * s2, lane), p1, o0);
                o1 = MFMA32(ldfrag_perm_sw<3>(Vt, 144, 32, 32 + 16 * s2, lane), p1, o1);
            }
        }
        __syncthreads();
    }
#undef ATT_STAGE
    lsum += __shfl_xor(lsum, 32);
    const float inv = 1.f / lsum;
    const bf16* agp = H + qrow * HP + C_AG + h * 64;
    bf16* op = A.BR + qrow * DM + 1536 + h * 64;
    u32x2 agl[4][2];
#pragma unroll
    for (int g = 0; g < 4; ++g) { agl[g][0] = *(const u32x2*)(agp + 8 * g + 4 * hh); agl[g][1] = *(const u32x2*)(agp + 32 + 8 * g + 4 * hh); }
    asm volatile("" ::: "memory");
#pragma unroll
    for (int g = 0; g < 4; ++g) {
        const int d0 = 8 * g + 4 * hh;
        { const u32x2 ag = agl[g][0];
          u32x2 w; w.x = pk2(silu(bflo(ag.x)) * o0[4 * g] * inv, silu(bfhi(ag.x)) * o0[4 * g + 1] * inv);
          w.y = pk2(silu(bflo(ag.y)) * o0[4 * g + 2] * inv, silu(bfhi(ag.y)) * o0[4 * g + 3] * inv);
          *(u32x2*)(op + d0) = w; }
        { const u32x2 ag = agl[g][1];
          u32x2 w; w.x = pk2(silu(bflo(ag.x)) * o1[4 * g] * inv, silu(bfhi(ag.x)) * o1[4 * g + 1] * inv);
          w.y = pk2(silu(bflo(ag.y)) * o1[4 * g + 2] * inv, silu(bfhi(ag.y)) * o1[4 * g + 3] * inv);
          *(u32x2*)(op + 32 + d0) = w; }
    }
}

__device__ __forceinline__ void gmlp_prompt_unit(const MixArgs& A, int unit, LAS uchar* lds, int tid, int lane, int wave) {
    const int g = unit & 3, blk = (unit >> 2) & 15, b = unit >> 6;
    LAS uchar* Wm = lds; LAS uchar* Yt = lds + 34816; LAS float* bsl = (LAS float*)(lds + 69632);
    const bf16* H = A.H;
    const size_t r0 = (size_t)b * SEQ + blk * 128;
    __syncthreads();
    LAS uchar* Nat = lds + 70656;
    {
        const int j0 = (lane & 31) * 4;
        f32x4 wa[8];
#pragma unroll
        for (int q = 0; q < 8; ++q) { const int i = wave * 16 + q * 2 + (lane >> 5); wa[q] = *(const f32x4*)(A.gws + ((size_t)g * 128 + i) * 128 + j0); }
        asm volatile("" ::: "memory");
#pragma unroll
        for (int q = 0; q < 8; ++q) { const int i = wave * 16 + q * 2 + (lane >> 5); const f32x4 a = wa[q];
            *(LAS u32x2*)(Wm + i * 272 + j0 * 2) = (u32x2){pk2(a.x, a.y), pk2(a.z, a.w)}; }
        if (tid < 128) bsl[tid] = A.gbs[g * 128 + tid];
    }
    {
        const int l15 = lane & 15, rs4 = lane >> 4;
        const f32x4 lg0 = *(const f32x4*)(A.ln_g + g * 128 + l15 * 8), lg1 = *(const f32x4*)(A.ln_g + g * 128 + l15 * 8 + 4);
        const f32x4 lb0 = *(const f32x4*)(A.ln_b + g * 128 + l15 * 8), lb1 = *(const f32x4*)(A.ln_b + g * 128 + l15 * 8 + 4);
        u32x4 v[4][4];
#pragma unroll
        for (int gq = 0; gq < 4; ++gq) { const bf16* mp = H + (r0 + wave * 16 + gq * 4 + rs4) * HP + C_MV + l15 * 8;
#pragma unroll
            for (int i = 0; i < 4; ++i) v[gq][i] = *(const u32x4*)(mp + i * 128); }
#pragma unroll
        for (int gq = 0; gq < 4; ++gq) {
            float sm = 0.f, ss = 0.f;
#pragma unroll
            for (int i = 0; i < 4; ++i) { const u32x4 t = v[gq][i];
                const float x0 = bflo(t.x), x1 = bfhi(t.x), x2 = bflo(t.y), x3 = bfhi(t.y), x4 = bflo(t.z), x5 = bfhi(t.z), x6 = bflo(t.w), x7 = bfhi(t.w);
                sm += ((x0 + x1) + (x2 + x3)) + ((x4 + x5) + (x6 + x7));
                ss += ((x0 * x0 + x1 * x1) + (x2 * x2 + x3 * x3)) + ((x4 * x4 + x5 * x5) + (x6 * x6 + x7 * x7)); }
#pragma unroll
            for (int o = 1; o < 16; o <<= 1) { sm += __shfl_xor(sm, o); ss += __shfl_xor(ss, o); }
            const float mean = sm * (1.f / 512.f); float var = ss * (1.f / 512.f) - mean * mean; var = var < 0.f ? 0.f : var;
            const float rstd = __builtin_amdgcn_rsqf(var + NORM_EPS);
            const u32x4 t = (g == 0) ? v[gq][0] : (g == 1) ? v[gq][1] : (g == 2) ? v[gq][2] : v[gq][3];
            u32x4 w;
            w.x = pk2((bflo(t.x) - mean) * rstd * lg0.x + lb0.x, (bfhi(t.x) - mean) * rstd * lg0.y + lb0.y); w.y = pk2((bflo(t.y) - mean) * rstd * lg0.z + lb0.z, (bfhi(t.y) - mean) * rstd * lg0.w + lb0.w);
            w.z = pk2((bflo(t.z) - mean) * rstd * lg1.x + lb1.x, (bfhi(t.z) - mean) * rstd * lg1.y + lb1.y); w.w = pk2((bflo(t.w) - mean) * rstd * lg1.z + lb1.z, (bfhi(t.w) - mean) * rstd * lg1.w + lb1.w);
            *(LAS u32x4*)(Nat + (wave * 16 + gq * 4 + rs4) * 272 + l15 * 16) = w; }
    }
    __syncthreads();
    {
        const int row = tid & 127, c0 = (tid >> 7) * 32;
#pragma unroll
        for (int q = 0; q < 4; ++q) { const u32x4 t = *(const LAS u32x4*)(Nat + row * 272 + (c0 + 8 * q) * 2);
            const unsigned tv[4] = {t.x, t.y, t.z, t.w};
#pragma unroll
            for (int k = 0; k < 4; ++k) { *(LAS bf16*)(Yt + (c0 + 8 * q + 2 * k) * 272 + row * 2) = (bf16)(tv[k] & 0xffffu); *(LAS bf16*)(Yt + (c0 + 8 * q + 2 * k + 1) * 272 + row * 2) = (bf16)(tv[k] >> 16); } }
    }
    __syncthreads();
    const int ib = wave >> 1, hh = lane >> 5;
    const int kmax = (ib < 2) ? 64 : 128;
    const int i = 32 * ib + (lane & 31);
    const size_t row = r0 + i;
    u32x2 mgl[2][4], mul_[2][4];
#pragma unroll
    for (int cc = 0; cc < 2; ++cc)
#pragma unroll
        for (int q = 0; q < 4; ++q) { const int ch = g * 128 + 32 * ((wave & 1) * 2 + cc) + 8 * q + 4 * hh;
            mgl[cc][q] = *(const u32x2*)(H + row * HP + C_MG + ch); mul_[cc][q] = *(const u32x2*)(H + row * HP + C_MU + ch); }
#pragma unroll
    for (int cc = 0; cc < 2; ++cc) {
        const int cb = (wave & 1) * 2 + cc;
        f32x16 acc = {};
        for (int k0 = 0; k0 < kmax; k0 += 16) acc = MFMA32(ldfrag(Yt, 272, 32 * cb, k0, lane), ldfrag(Wm, 272, 32 * ib, k0, lane), acc);
        const float bsi = bsl[i];
        u32x2 mgv[4], muv[4];
#pragma unroll
        for (int q = 0; q < 4; ++q) { mgv[q] = mgl[cc][q]; muv[q] = mul_[cc][q]; }
#pragma unroll
        for (int q = 0; q < 4; ++q) { const int ch = g * 128 + 32 * cb + 8 * q + 4 * hh;
            u32x2 w; w.x = pk2(silu(bflo(mgv[q].x)) * bflo(muv[q].x) * (acc[4 * q] + bsi), silu(bfhi(mgv[q].x)) * bfhi(muv[q].x) * (acc[4 * q + 1] + bsi));
            w.y = pk2(silu(bflo(mgv[q].y)) * bflo(muv[q].y) * (acc[4 * q + 2] + bsi), silu(bfhi(mgv[q].y)) * bfhi(muv[q].y) * (acc[4 * q + 3] + bsi));
            *(u32x2*)(A.BR + row * DM + 1024 + ch) = w; }
    }
}

__device__ __forceinline__ void conv_prompt_unit(const MixArgs& A, int unit, int tid) {
    const bf16* H = A.H;
    const int r0 = unit * 64, b = r0 / SEQ, t0 = r0 % SEQ;
    const int ch0 = (tid & 63) * 8, ro = tid >> 6;
    float w0[8], w1[8], w2[8];
#pragma unroll
    for (int k = 0; k < 8; ++k) { w0[k] = A.conv_w[ch0 + k]; w1[k] = A.conv_w[512 + ch0 + k]; w2[k] = A.conv_w[1024 + ch0 + k]; }
    float zm2[8], zm1[8];
    const int tt0 = t0 + ro * 8;
    if (tt0 >= 2) {
        const size_t ra = (size_t)b * SEQ + tt0 - 2;
        const u32x4 c2 = *(const u32x4*)(H + ra * HP + C_CC + ch0), x2 = *(const u32x4*)(H + ra * HP + C_CX + ch0);
        const u32x4 c1 = *(const u32x4*)(H + (ra + 1) * HP + C_CC + ch0), x1 = *(const u32x4*)(H + (ra + 1) * HP + C_CX + ch0);
        zm2[0] = bflo(c2.x) * bflo(x2.x); zm2[1] = bfhi(c2.x) * bfhi(x2.x); zm2[2] = bflo(c2.y) * bflo(x2.y); zm2[3] = bfhi(c2.y) * bfhi(x2.y);
        zm2[4] = bflo(c2.z) * bflo(x2.z); zm2[5] = bfhi(c2.z) * bfhi(x2.z); zm2[6] = bflo(c2.w) * bflo(x2.w); zm2[7] = bfhi(c2.w) * bfhi(x2.w);
        zm1[0] = bflo(c1.x) * bflo(x1.x); zm1[1] = bfhi(c1.x) * bfhi(x1.x); zm1[2] = bflo(c1.y) * bflo(x1.y); zm1[3] = bfhi(c1.y) * bfhi(x1.y);
        zm1[4] = bflo(c1.z) * bflo(x1.z); zm1[5] = bfhi(c1.z) * bfhi(x1.z); zm1[6] = bflo(c1.w) * bflo(x1.w); zm1[7] = bfhi(c1.w) * bfhi(x1.w);
    } else {
#pragma unroll
        for (int k = 0; k < 8; ++k) { zm2[k] = 0.f; zm1[k] = 0.f; }
    }
#pragma unroll
    for (int hf = 0; hf < 2; ++hf) {
        u32x4 lcc[4], lcx[4], lcb[4], lcg[4];
#pragma unroll
        for (int k4 = 0; k4 < 4; ++k4) { const size_t row = (size_t)b * SEQ + tt0 + hf * 4 + k4;
            lcc[k4] = __builtin_nontemporal_load((const u32x4*)(H + row * HP + C_CC + ch0)); lcx[k4] = __builtin_nontemporal_load((const u32x4*)(H + row * HP + C_CX + ch0));
            lcb[k4] = __builtin_nontemporal_load((const u32x4*)(H + row * HP + C_CB + ch0)); lcg[k4] = __builtin_nontemporal_load((const u32x4*)(H + row * HP + C_CG + ch0)); }
        asm volatile("" ::: "memory");
#pragma unroll
    for (int k4 = 0; k4 < 4; ++k4) {
        const int tt = tt0 + hf * 4 + k4; const size_t row = (size_t)b * SEQ + tt;
        const u32x4 cc = lcc[k4], cx = lcx[k4], cb = lcb[k4], cg = lcg[k4];
        float z[8], bv[8], gv[8], o[8];
        z[0] = bflo(cc.x) * bflo(cx.x); z[1] = bfhi(cc.x) * bfhi(cx.x); z[2] = bflo(cc.y) * bflo(cx.y); z[3] = bfhi(cc.y) * bfhi(cx.y);
        z[4] = bflo(cc.z) * bflo(cx.z); z[5] = bfhi(cc.z) * bfhi(cx.z); z[6] = bflo(cc.w) * bflo(cx.w); z[7] = bfhi(cc.w) * bfhi(cx.w);
        bv[0] = bflo(cb.x); bv[1] = bfhi(cb.x); bv[2] = bflo(cb.y); bv[3] = bfhi(cb.y); bv[4] = bflo(cb.z); bv[5] = bfhi(cb.z); bv[6] = bflo(cb.w); bv[7] = bfhi(cb.w);
        gv[0] = bflo(cg.x); gv[1] = bfhi(cg.x); gv[2] = bflo(cg.y); gv[3] = bfhi(cg.y); gv[4] = bflo(cg.z); gv[5] = bfhi(cg.z); gv[6] = bflo(cg.w); gv[7] = bfhi(cg.w);
#pragma unroll
        for (int k = 0; k < 8; ++k) { const float y = w0[k] * zm2[k] + w1[k] * zm1[k] + w2[k] * z[k]; o[k] = silu(gv[k]) * (bv[k] * y); }
        u32x4 w; w.x = pk2(o[0], o[1]); w.y = pk2(o[2], o[3]); w.z = pk2(o[4], o[5]); w.w = pk2(o[6], o[7]);
        *(u32x4*)(A.BR + row * DM + 512 + ch0) = w;
        if (tt >= SEQ - 2) { float* sp = A.out + O_PCONV + (((size_t)A.l * NB + b) * 2 + (tt - (SEQ - 2))) * 512 + ch0;
            *(f32x4*)sp = (f32x4){z[0], z[1], z[2], z[3]}; *(f32x4*)(sp + 4) = (f32x4){z[4], z[5], z[6], z[7]}; }
#pragma unroll
        for (int k = 0; k < 8; ++k) { zm2[k] = zm1[k]; zm1[k] = z[k]; }
    }
    }
}

__device__ __forceinline__ u32x4 kv_copy_load(const MixArgs& A, int item) {
    const int e = item & 63, kv = (item >> 6) & 1, t = (item >> 7) & 511, b = item >> 16;
    const size_t row = (size_t)b * SEQ + (SEQ - 512) + t;
    return *(const u32x4*)(A.H + row * HP + (kv ? C_AV : C_AK) + e * 8);
}
__device__ __forceinline__ void kv_copy_store(const MixArgs& A, int item, u32x4 v) {
    const int e = item & 63, kv = (item >> 6) & 1, t = (item >> 7) & 511, b = item >> 16;
    float* op = A.out + (kv ? O_PV : O_PK) + (((size_t)A.l * NB + b) * 512 + t) * 512 + e * 8;
    *(f32x4*)op = (f32x4){bflo(v.x), bfhi(v.x), bflo(v.y), bfhi(v.y)}; *(f32x4*)(op + 4) = (f32x4){bflo(v.z), bfhi(v.z), bflo(v.w), bfhi(v.w)};
}

struct RuLd { u32x2 a, bb; u32x4 v0, v1; };
__device__ __forceinline__ void ru_load(const MixArgs& A, int unit, int tid, RuLd& L) {
    const int c = unit & 31, h = (unit >> 5) & 3, b = unit >> 7, j = tid >> 3, pp = tid & 7;
    const bf16* rp = A.H + ((size_t)b * SEQ + c * 64 + j) * HP;
    L.a = *(const u32x2*)(rp + C_RK + h * 64 + pp * 4); L.bb = *(const u32x2*)(rp + C_RK + h * 64 + 32 + pp * 4);
    L.v0 = *(const u32x4*)(rp + C_RV + h * 128 + pp * 16); L.v1 = *(const u32x4*)(rp + C_RV + h * 128 + pp * 16 + 8);
}
__device__ __forceinline__ void ret_u_unit(const MixArgs& A, int unit, int nxt, RuLd& L, LAS uchar* lds, int tid, int lane, int wave) {
    const int c = unit & 31, h = (unit >> 5) & 3, b = unit >> 7;
    const bf16* H = A.H;
    LAS uchar* Xt = lds; LAS uchar* Yt = lds + 9216;
    const float l2g = __builtin_amdgcn_logf(1.f - ex2(-5.f - (float)h));
    __syncthreads();
    {
        const int j = tid >> 3, pp = tid & 7, i0 = pp * 4, js = (j ^ (pp << 3)) * 2;
        const u32x2 a = L.a, bb = L.bb; const u32x4 v0 = L.v0, v1 = L.v1;
        const float x1[4] = {bflo(a.x), bfhi(a.x), bflo(a.y), bfhi(a.y)}, x2[4] = {bflo(bb.x), bfhi(bb.x), bflo(bb.y), bfhi(bb.y)};
        const float sc = 0.125f * ex2((float)(63 - j) * l2g);
#pragma unroll
        for (int k = 0; k < 4; ++k) { float cs, sn; rot_cs(c * 64 + j, i0 + k, cs, sn);
            *(LAS bf16*)(Xt + (i0 + k) * 144 + js) = f2bf((x1[k] * cs - x2[k] * sn) * sc);
            *(LAS bf16*)(Xt + (32 + i0 + k) * 144 + js) = f2bf((x1[k] * sn + x2[k] * cs) * sc); }
        const unsigned vv[8] = {v0.x, v0.y, v0.z, v0.w, v1.x, v1.y, v1.z, v1.w};
#pragma unroll
        for (int k = 0; k < 8; ++k) { *(LAS bf16*)(Yt + (pp * 16 + 2 * k) * 144 + js) = (bf16)(vv[k] & 0xffffu); *(LAS bf16*)(Yt + (pp * 16 + 2 * k + 1) * 144 + js) = (bf16)(vv[k] >> 16); }
    }
    if (nxt >= 0) ru_load(A, nxt, tid, L);
    __syncthreads();
    const int kb = wave >> 2, vb = wave & 3, hh = lane >> 5;
    f32x16 acc = {};
#pragma unroll
    for (int ks = 0; ks < 4; ++ks) acc = MFMA32(ldfrag_sw<4>(Yt, 144, 32 * vb, 16 * ks, lane), ldfrag_sw<2>(Xt, 144, 32 * kb, 16 * ks, lane), acc);
    float* up = A.U + (size_t)unit * 8192 + 32 * kb + (lane & 31);
#pragma unroll
    for (int r = 0; r < 16; ++r) { const int vd = 32 * vb + (r & 3) + 8 * (r >> 2) + 4 * hh; up[vd * 64] = acc[r]; }
}

__device__ __forceinline__ void ret_prefix_item(const MixArgs& A, int item) {
    const int bh = item >> 12, e2 = (item & 4095) * 2, h = bh & 3, b = bh >> 2;
    const float g64 = ex2(64.f * __builtin_amdgcn_logf(1.f - ex2(-5.f - (float)h)));
    const float* up = A.U + (size_t)bh * 32 * 8192 + e2;
    unsigned* sp = (unsigned*)(A.SB + (size_t)bh * 32 * 8192 + e2);
    f32x2 u[32];
#pragma unroll
    for (int c = 0; c < 32; ++c) u[c] = __builtin_nontemporal_load((const f32x2*)(up + (size_t)c * 8192));
    f32x2 s = {0.f, 0.f};
#pragma unroll
    for (int c = 0; c < 32; ++c) { s = s * g64 + u[c]; sp[(size_t)c * 4096] = pk2(s.x, s.y); }
    const int vd = e2 >> 6, kd = e2 & 63;
    float* op = A.out + O_PRET + (((size_t)A.l * NB + b) * 4 + h) * 8192 + vd;
    op[kd * 128] = s.x; op[(kd + 1) * 128] = s.y;
}

struct RoLd { u32x2 qa, qb, ka, kb2; u32x4 v0, v1, s0, s1; };
__device__ __forceinline__ void ro_load(const MixArgs& A, int unit, int tid, RoLd& L) {
    const int c = unit & 31, h = (unit >> 5) & 3, b = unit >> 7, j = tid >> 3, pp = tid & 7;
    const bf16* rp = A.H + ((size_t)b * SEQ + c * 64 + j) * HP;
    L.qa = *(const u32x2*)(rp + C_RQ + h * 64 + pp * 4); L.qb = *(const u32x2*)(rp + C_RQ + h * 64 + 32 + pp * 4);
    L.ka = *(const u32x2*)(rp + C_RK + h * 64 + pp * 4); L.kb2 = *(const u32x2*)(rp + C_RK + h * 64 + 32 + pp * 4);
    L.v0 = *(const u32x4*)(rp + C_RV + h * 128 + pp * 16); L.v1 = *(const u32x4*)(rp + C_RV + h * 128 + pp * 16 + 8);
    L.s0 = (u32x4){0u, 0u, 0u, 0u}; L.s1 = (u32x4){0u, 0u, 0u, 0u};
    if (c > 0) { const u32x4* sp = (const u32x4*)(A.SB + (size_t)(unit - 1) * 8192 + (tid >> 2) * 64 + (tid & 3) * 16); L.s0 = __builtin_nontemporal_load(sp); L.s1 = __builtin_nontemporal_load(sp + 1); }
}
__device__ __forceinline__ void ret_out_unit(const MixArgs& A, int unit, int nxt, RoLd& L, LAS uchar* lds, int tid, int lane, int wave) {
    const int c = unit & 31, h = (unit >> 5) & 3, b = unit >> 7;
    const bf16* H = A.H;
    LAS uchar* Qs = lds; LAS uchar* Qd = lds + 9216; LAS uchar* Ks = lds + 18432; LAS uchar* Vt = lds + 27648; LAS uchar* St = lds + 46080;
    LAS float* part = (LAS float*)(lds + 64512);
    const size_t r0 = (size_t)b * SEQ + c * 64;
    const float l2g = __builtin_amdgcn_logf(1.f - ex2(-5.f - (float)h));
    __syncthreads();
    {
        const int j = tid >> 3, pp = tid & 7, i0 = pp * 4, js = (j ^ (pp << 3)) * 2;
        const u32x2 qa = L.qa, qb = L.qb, ka = L.ka, kb2 = L.kb2; const u32x4 v0 = L.v0, v1 = L.v1;
        const float q1[4] = {bflo(qa.x), bfhi(qa.x), bflo(qa.y), bfhi(qa.y)}, q2[4] = {bflo(qb.x), bfhi(qb.x), bflo(qb.y), bfhi(qb.y)};
        const float k1[4] = {bflo(ka.x), bfhi(ka.x), bflo(ka.y), bfhi(ka.y)}, k2[4] = {bflo(kb2.x), bfhi(kb2.x), bflo(kb2.y), bfhi(kb2.y)};
        const float qdec = ex2((float)(j + 1) * l2g);
        float qa_[4], qb_[4], ka_[4], kb_[4];
#pragma unroll
        for (int k = 0; k < 4; ++k) { float cs, sn; rot_cs(c * 64 + j, i0 + k, cs, sn);
            qa_[k] = q1[k] * cs - q2[k] * sn; qb_[k] = q1[k] * sn + q2[k] * cs;
            ka_[k] = (k1[k] * cs - k2[k] * sn) * 0.125f; kb_[k] = (k1[k] * sn + k2[k] * cs) * 0.125f; }
        *(LAS u32x2*)(Qs + j * 144 + i0 * 2) = (u32x2){pk2(qa_[0], qa_[1]), pk2(qa_[2], qa_[3])};
        *(LAS u32x2*)(Qs + j * 144 + (32 + i0) * 2) = (u32x2){pk2(qb_[0], qb_[1]), pk2(qb_[2], qb_[3])};
        *(LAS u32x2*)(Qd + j * 144 + i0 * 2) = (u32x2){pk2(qa_[0] * qdec, qa_[1] * qdec), pk2(qa_[2] * qdec, qa_[3] * qdec)};
        *(LAS u32x2*)(Qd + j * 144 + (32 + i0) * 2) = (u32x2){pk2(qb_[0] * qdec, qb_[1] * qdec), pk2(qb_[2] * qdec, qb_[3] * qdec)};
        *(LAS u32x2*)(Ks + j * 144 + i0 * 2) = (u32x2){pk2(ka_[0], ka_[1]), pk2(ka_[2], ka_[3])};
        *(LAS u32x2*)(Ks + j * 144 + (32 + i0) * 2) = (u32x2){pk2(kb_[0], kb_[1]), pk2(kb_[2], kb_[3])};
        const unsigned vv[8] = {v0.x, v0.y, v0.z, v0.w, v1.x, v1.y, v1.z, v1.w};
#pragma unroll
        for (int k = 0; k < 8; ++k) { *(LAS bf16*)(Vt + (pp * 16 + 2 * k) * 144 + js) = (bf16)(vv[k] & 0xffffu); *(LAS bf16*)(Vt + (pp * 16 + 2 * k + 1) * 144 + js) = (bf16)(vv[k] >> 16); }
    }
    {
        const int vd = tid >> 2, part = tid & 3;
        *(LAS u32x4*)(St + vd * 144 + part * 32) = L.s0; *(LAS u32x4*)(St + vd * 144 + part * 32 + 16) = L.s1;
    }
    if (nxt >= 0) ro_load(A, nxt, tid, L);
    __syncthreads();
    const int ib = wave & 1, vb = wave >> 1, hh = lane >> 5;
    const int i = 32 * ib + (lane & 31);
    u32x2 rgl[4];
#pragma unroll
    for (int g = 0; g < 4; ++g) rgl[g] = *(const u32x2*)(H + (r0 + i) * HP + C_RG + h * 128 + 32 * vb + 8 * g + 4 * hh);
    f32x16 acc = {};
    for (int jb = 0; jb <= ib; ++jb) {
        f32x16 t = {};
#pragma unroll
        for (int ks = 0; ks < 4; ++ks) t = MFMA32(ldfrag(Ks, 144, 32 * jb, 16 * ks, lane), ldfrag(Qs, 144, 32 * ib, 16 * ks, lane), t);
#pragma unroll
        for (int r = 0; r < 16; ++r) { const int j = 32 * jb + (r & 3) + 8 * (r >> 2) + 4 * hh; t[r] = (i >= j) ? t[r] * ex2((float)(i - j) * l2g) : 0.f; }
#pragma unroll
        for (int s2 = 0; s2 < 2; ++s2) acc = MFMA32(ldfrag_perm_sw<4>(Vt, 144, 32 * vb, 32 * jb + 16 * s2, lane), acc_frag(t, s2), acc);
    }
#pragma unroll
    for (int ks = 0; ks < 4; ++ks) acc = MFMA32(ldfrag(St, 144, 32 * vb, 16 * ks, lane), ldfrag(Qd, 144, 32 * ib, 16 * ks, lane), acc);
    float s1 = 0.f, s2 = 0.f;
#pragma unroll
    for (int r = 0; r < 16; ++r) { s1 += acc[r]; s2 += acc[r] * acc[r]; }
    s1 += __shfl_xor(s1, 32); s2 += __shfl_xor(s2, 32);
    if (hh == 0) { part[(vb * 64 + i) * 2] = s1; part[(vb * 64 + i) * 2 + 1] = s2; }
    __syncthreads();
    float ts = 0.f, tss = 0.f;
#pragma unroll
    for (int p = 0; p < 4; ++p) { ts += part[(p * 64 + i) * 2]; tss += part[(p * 64 + i) * 2 + 1]; }
    const float mean = ts * (1.f / 128.f); float var = tss * (1.f / 128.f) - mean * mean; var = var < 0.f ? 0.f : var;
    const float rstd = __builtin_amdgcn_rsqf(var + NORM_EPS);
    bf16* op = A.BR + (r0 + i) * DM + h * 128 + 32 * vb;
#pragma unroll
    for (int g = 0; g < 4; ++g) { const int d0 = 8 * g + 4 * hh;
        const u32x2 rg = rgl[g];
        u32x2 w; w.x = pk2(silu(bflo(rg.x)) * (acc[4 * g] - mean) * rstd, silu(bfhi(rg.x)) * (acc[4 * g + 1] - mean) * rstd);
        w.y = pk2(silu(bflo(rg.y)) * (acc[4 * g + 2] - mean) * rstd, silu(bfhi(rg.y)) * (acc[4 * g + 3] - mean) * rstd);
        *(u32x2*)(op + d0) = w; }
}

__device__ __forceinline__ void ret_sample_unit(const MixArgs& A, int unit, LAS uchar* lds, int tid) {
    const int h = unit & 3, b = unit >> 2;
    const bf16* H = A.H;
    LAS float* q = (LAS float*)lds; LAS float* k = q + 1024; LAS float* v = k + 1024; LAS float* inner = v + 2048; LAS float* opart = inner + 256;
    const size_t r0 = (size_t)MP + b * DS;
    const float l2g = __builtin_amdgcn_logf(1.f - ex2(-5.f - (float)h));
    __syncthreads();
    { const int i = tid >> 5, pi = tid & 31;
      const bf16* qp = H + (r0 + i) * HP + C_RQ + h * 64; const bf16* kp = H + (r0 + i) * HP + C_RK + h * 64;
      float cs, sn; rot_cs(SEQ + i, pi, cs, sn);
      const float q1 = bf2f(qp[pi]), q2 = bf2f(qp[32 + pi]), k1 = bf2f(kp[pi]), k2 = bf2f(kp[32 + pi]);
      q[i * 64 + pi] = q1 * cs - q2 * sn; q[i * 64 + 32 + pi] = q1 * sn + q2 * cs;
      k[i * 64 + pi] = (k1 * cs - k2 * sn) * 0.125f; k[i * 64 + 32 + pi] = (k1 * sn + k2 * cs) * 0.125f;
#pragma unroll
      for (int e = 0; e < 4; ++e) { const int idx = tid * 4 + e, vi = idx >> 7, vd = idx & 127; v[idx] = bf2f(H[(r0 + vi) * HP + C_RV + h * 128 + vd]); } }
    __syncthreads();
    if (tid < 256) { const int i = tid >> 4, j = tid & 15; float d = 0.f;
        if (j <= i) { for (int e = 0; e < 64; ++e) d += q[i * 64 + e] * k[j * 64 + e]; d *= ex2((float)(i - j) * l2g); }
        inner[tid] = d; }
    { const int vd = tid & 127, kq = tid >> 7;
      const float* sp = A.state_ret + (((size_t)b * 4 + h) * 64 + kq * 16) * 128 + vd;
      float s[16];
#pragma unroll
      for (int kk = 0; kk < 16; ++kk) s[kk] = __builtin_nontemporal_load(sp + kk * 128);
      for (int i = 0; i < 16; ++i) { float a = 0.f;
#pragma unroll
          for (int kk = 0; kk < 16; ++kk) a += q[i * 64 + kq * 16 + kk] * s[kk];
          opart[(kq * 16 + i) * 128 + vd] = a * ex2((float)(i + 1) * l2g); }
      const float g16 = ex2(16.f * l2g);
      float* op = A.out + O_SRET + ((((size_t)A.l * DB + b) * 4 + h) * 64 + kq * 16) * 128 + vd;
      float dv[16];
#pragma unroll
      for (int j = 0; j < 16; ++j) dv[j] = ex2((float)(15 - j) * l2g) * v[j * 128 + vd];
#pragma unroll
      for (int kk = 0; kk < 16; ++kk) { float a = g16 * s[kk];
#pragma unroll
          for (int j = 0; j < 16; ++j) a += dv[j] * k[j * 64 + kq * 16 + kk];
          op[kk * 128] = a; } }
    __syncthreads();
    { const int i = tid >> 5, vq = tid & 31, vd = vq * 4;
      float o[4] = {0.f, 0.f, 0.f, 0.f};
#pragma unroll
      for (int p = 0; p < 4; ++p)
#pragma unroll
          for (int e = 0; e < 4; ++e) o[e] += opart[(p * 16 + i) * 128 + vd + e];
      for (int j = 0; j <= i; ++j) { const float w = inner[i * 16 + j];
#pragma unroll
          for (int e = 0; e < 4; ++e) o[e] += w * v[j * 128 + vd + e]; }
      float s1 = (o[0] + o[1]) + (o[2] + o[3]), s2 = (o[0] * o[0] + o[1] * o[1]) + (o[2] * o[2] + o[3] * o[3]);
#pragma unroll
      for (int m = 1; m < 32; m <<= 1) { s1 += __shfl_xor(s1, m); s2 += __shfl_xor(s2, m); }
      const float mean = s1 * (1.f / 128.f); float var = s2 * (1.f / 128.f) - mean * mean; var = var < 0.f ? 0.f : var;
      const float rstd = __builtin_amdgcn_rsqf(var + NORM_EPS);
      const u32x2 rg = *(const u32x2*)(H + (r0 + i) * HP + C_RG + h * 128 + vd);
      u32x2 w; w.x = pk2(silu(bflo(rg.x)) * (o[0] - mean) * rstd, silu(bfhi(rg.x)) * (o[1] - mean) * rstd);
      w.y = pk2(silu(bflo(rg.y)) * (o[2] - mean) * rstd, silu(bfhi(rg.y)) * (o[3] - mean) * rstd);
      *(u32x2*)(A.BR + (r0 + i) * DM + h * 128 + vd) = w; }
}

__device__ __forceinline__ void attn_sample_unit(const MixArgs& A, int unit, LAS uchar* lds, int tid, int lane, int wave) {
    const int h = unit & 7, b = unit >> 3;
    const bf16* H = A.H;
    LAS uchar* Ks = lds; LAS float* S = (LAS float*)(lds + 78336); LAS float* tb = S + 16 * 545; LAS float* inv = tb + 260; LAS float* opart = (LAS float*)lds;
    constexpr int SP = 545;
    const size_t r0 = (size_t)MP + b * DS;
    __syncthreads();
    for (int i = tid; i < 257; i += NTHR) tb[i] = A.relb[h * 257 + i];
    bf16x8 qf[4];
    { const int q = lane & 31, hh = lane >> 5;
      u32x4 tq[4];
#pragma unroll
      for (int ks = 0; ks < 4; ++ks) tq[ks] = *(const u32x4*)(H + (r0 + (q & 15)) * HP + C_AQ + h * 64 + ks * 16 + 8 * hh);
#pragma unroll
      for (int ks = 0; ks < 4; ++ks) { u32x4 t = tq[ks];
          t.x = pk2(bflo(t.x) * 0.125f, bfhi(t.x) * 0.125f); t.y = pk2(bflo(t.y) * 0.125f, bfhi(t.y) * 0.125f); t.z = pk2(bflo(t.z) * 0.125f, bfhi(t.z) * 0.125f); t.w = pk2(bflo(t.w) * 0.125f, bfhi(t.w) * 0.125f);
          if (q >= 16) t = (u32x4){0u, 0u, 0u, 0u};
          qf[ks] = __builtin_bit_cast(bf16x8, t); } }
    {
        const int l16 = tid & 15, k0 = tid >> 4;
        f32x4 kv[16];
#pragma unroll
        for (int k = 0; k < 16; ++k) kv[k] = __builtin_nontemporal_load((const f32x4*)(A.cache_k + (((size_t)b * 512 + k0 + 32 * k) * 8 + h) * 64 + l16 * 4));
#pragma unroll
        for (int k = 0; k < 16; ++k) *(LAS u32x2*)(Ks + (k0 + 32 * k) * 144 + l16 * 8) = (u32x2){pk2(kv[k].x, kv[k].y), pk2(kv[k].z, kv[k].w)};
        if (tid < 128) { const int kk = tid >> 3, part = tid & 7;
            const u32x4 t = *(const u32x4*)(H + (r0 + kk) * HP + C_AK + h * 64 + part * 8);
            *(LAS u32x4*)(Ks + (512 + kk) * 144 + part * 16) = t;
            float* ok = A.out + O_SK + ((((size_t)A.l * DB + b) * DS + kk) * 8 + h) * 64 + part * 8;
            *(f32x4*)ok = (f32x4){bflo(t.x), bfhi(t.x), bflo(t.y), bfhi(t.y)}; *(f32x4*)(ok + 4) = (f32x4){bflo(t.z), bfhi(t.z), bflo(t.w), bfhi(t.w)};
        } else if (tid < 256) { const int kk = (tid - 128) >> 3, part = tid & 7; *(LAS u32x4*)(Ks + (528 + kk) * 144 + part * 16) = (u32x4){0u, 0u, 0u, 0u}; }
    }
    const int d4 = (tid & 15) * 4, part = tid >> 4;
    f32x4 vv[16];
    { const float* vp = A.cache_v + (((size_t)b * 512 + part * 16) * 8 + h) * 64 + d4;
#pragma unroll
      for (int jj = 0; jj < 16; ++jj) vv[jj] = __builtin_nontemporal_load((const f32x4*)(vp + (size_t)jj * 512)); }
    const u32x2 tvn = *(const u32x2*)(H + (r0 + (part & 15)) * HP + C_AV + h * 64 + d4);
    const unsigned agv = *(const unsigned*)(H + (r0 + (tid >> 5)) * HP + C_AG + h * 64 + (tid & 31) * 2);
    __syncthreads();
    { const int q = lane & 31, hh = lane >> 5;
      for (int jb = wave; jb < 17; jb += 8) {
          f32x16 acc = {};
#pragma unroll
          for (int ks = 0; ks < 4; ++ks) acc = MFMA32(ldfrag(Ks, 144, 32 * jb, 16 * ks, lane), qf[ks], acc);
          if (q < 16) {
#pragma unroll
              for (int r = 0; r < 16; ++r) { const int j = 32 * jb + (r & 3) + 8 * (r >> 2) + 4 * hh;
                  int idx = q + 512 - j; idx = idx < -128 ? -128 : (idx > 128 ? 128 : idx);
                  if (j < 528) S[q * SP + j] = acc[r] + tb[idx + 128]; } } } }
    __syncthreads();
#pragma unroll
    for (int rr = 0; rr < 2; ++rr) { const int i = wave * 2 + rr;
        float m = -1e30f;
        for (int j = lane; j < 528; j += 64) m = fmaxf(m, S[i * SP + j]);
        m = wave_max(m);
        float s = 0.f;
        for (int j = lane; j < 528; j += 64) { const float p = fexp(S[i * SP + j] - m); S[i * SP + j] = p; s += p; }
        s = wave_sum(s);
        if (lane == 0) inv[i] = 1.f / s; }
    __syncthreads();
    {
      f32x4 o[16];
#pragma unroll
      for (int i = 0; i < 16; ++i) o[i] = (f32x4){0.f, 0.f, 0.f, 0.f};
#pragma unroll
      for (int jj = 0; jj < 16; ++jj) { const int j = part * 16 + jj;
#pragma unroll
          for (int i = 0; i < 16; ++i) o[i] += S[i * SP + j] * vv[jj]; }
      if (part < 16) { const u32x2 t = tvn;
          const f32x4 vn = {bflo(t.x), bfhi(t.x), bflo(t.y), bfhi(t.y)};
          *(f32x4*)(A.out + O_SV + ((((size_t)A.l * DB + b) * DS + part) * 8 + h) * 64 + d4) = vn;
#pragma unroll
          for (int i = 0; i < 16; ++i) o[i] += S[i * SP + 512 + part] * vn; }
#pragma unroll
      for (int i = 0; i < 16; ++i) {
#pragma unroll
          for (int k = 0; k < 4; ++k) { o[i][k] += __shfl_xor(o[i][k], 16); o[i][k] += __shfl_xor(o[i][k], 32); } }
      if ((tid & 63) < 16) {
#pragma unroll
          for (int i = 0; i < 16; ++i) *(LAS f32x4*)(opart + (wave * 16 + i) * 64 + d4) = o[i]; } }
    __syncthreads();
    { const int i = tid >> 5, d2 = (tid & 31) * 2;
      float o0 = 0.f, o1 = 0.f;
#pragma unroll
      for (int p = 0; p < 8; ++p) { o0 += opart[(p * 16 + i) * 64 + d2]; o1 += opart[(p * 16 + i) * 64 + d2 + 1]; }
      const unsigned ag = agv;
      *(unsigned*)(A.BR + (r0 + i) * DM + 1536 + h * 64 + d2) = pk2(silu(bflo(ag)) * o0 * inv[i], silu(bfhi(ag)) * o1 * inv[i]); }
}

__device__ __forceinline__ void convgmlp_sample_unit(const MixArgs& A, int unit, LAS uchar* lds, int tid, int lane, int wave) {
    const int b = unit, ch = tid;
    const bf16* H = A.H;
    LAS float* st = (LAS float*)lds; LAS float* wsl = st + 32;
    const size_t r0 = (size_t)MP + b * DS;
    __syncthreads();
    for (int e = tid; e < 1024; e += NTHR) { const int g = e >> 8, i = (e >> 4) & 15, j = e & 15; wsl[e] = A.gws[((size_t)g * 128 + i) * 128 + j]; }
#pragma unroll
    for (int rr = 0; rr < 2; ++rr) { const int i = wave * 2 + rr;
        const u32x4 v = *(const u32x4*)(H + (r0 + i) * HP + C_MV + lane * 8);
        const float x[8] = {bflo(v.x), bfhi(v.x), bflo(v.y), bfhi(v.y), bflo(v.z), bfhi(v.z), bflo(v.w), bfhi(v.w)};
        float s = 0.f, ss = 0.f;
#pragma unroll
        for (int k = 0; k < 8; ++k) { s += x[k]; ss += x[k] * x[k]; }
        s = wave_sum(s); ss = wave_sum(ss);
        const float mean = s * (1.f / 512.f); float var = ss * (1.f / 512.f) - mean * mean; var = var < 0.f ? 0.f : var;
        if (lane == 0) { st[i * 2] = mean; st[i * 2 + 1] = __builtin_amdgcn_rsqf(var + NORM_EPS); } }
    __syncthreads();
    {
        const float w0 = A.conv_w[ch], w1 = A.conv_w[512 + ch], w2 = A.conv_w[1024 + ch];
        float zm2 = A.state_conv[((size_t)b * 2 + 0) * 512 + ch], zm1 = A.state_conv[((size_t)b * 2 + 1) * 512 + ch];
        bf16 hc[16], hx[16], hg[16], hb[16];
#pragma unroll
        for (int i = 0; i < 16; ++i) { const size_t row = r0 + i; hc[i] = H[row * HP + C_CC + ch]; hx[i] = H[row * HP + C_CX + ch]; hg[i] = H[row * HP + C_CG + ch]; hb[i] = H[row * HP + C_CB + ch]; }
        asm volatile("" ::: "memory");
#pragma unroll
        for (int i = 0; i < 16; ++i) { const size_t row = r0 + i;
            const float z = bf2f(hc[i]) * bf2f(hx[i]);
            const float y = w0 * zm2 + w1 * zm1 + w2 * z;
            A.BR[row * DM + 512 + ch] = f2bf(silu(bf2f(hg[i])) * (bf2f(hb[i]) * y));
            zm2 = zm1; zm1 = z; }
        float* sp = A.out + O_SCONV + ((size_t)A.l * DB + b) * 2 * 512 + ch;
        sp[0] = zm2; sp[512] = zm1;
    }
    {
        const float lg = A.ln_g[ch], lb = A.ln_b[ch];
        const int g = ch >> 7;
        float vn[16]; bf16 hv[16], hmg[16], hmu[16]; float gb[16];
#pragma unroll
        for (int i = 0; i < 16; ++i) { const size_t row = r0 + i; hv[i] = H[row * HP + C_MV + ch]; hmg[i] = H[row * HP + C_MG + ch]; hmu[i] = H[row * HP + C_MU + ch]; gb[i] = A.gbs[g * 128 + i]; }
        asm volatile("" ::: "memory");
#pragma unroll
        for (int i = 0; i < 16; ++i) { vn[i] = (bf2f(hv[i]) - st[i * 2]) * st[i * 2 + 1] * lg + lb;
            A.out[O_SGV + (((size_t)A.l * DB + b) * DS + i) * 512 + ch] = vn[i]; }
#pragma unroll
        for (int i = 0; i < 16; ++i) { float mix = gb[i];
#pragma unroll
            for (int j = 0; j < 16; ++j) mix += wsl[(g * 16 + i) * 16 + j] * vn[j];
            const size_t row = r0 + i;
            A.BR[row * DM + 1024 + ch] = f2bf(silu(bf2f(hmg[i])) * bf2f(hmu[i]) * mix); }
    }
}

struct Args { const float* in[17]; float* out; unsigned char* ws; int ph_lo, ph_hi; };
constexpr int N_PHASES = 2 + 7 * DEPTH;

__global__ void __launch_bounds__(NTHR, 2) enc_fwd(Args args) {
    extern __shared__ __attribute__((aligned(16))) unsigned char lds_raw[];
    LAS uchar* lds = (LAS uchar*)lds_raw;
    volatile LAS unsigned* MISC = (volatile LAS unsigned*)(lds + MISC_OFF);
#define LT() int tid = threadIdx.x; asm volatile("" : "+v"(tid)); const int lane = tid & 63, wave = __builtin_amdgcn_readfirstlane(tid >> 6); const int gw = bx * NWAVES + wave, NGW = G * NWAVES; (void)lane; (void)gw; (void)NGW
    const int G = gridDim.x, bx = blockIdx.x;
    typedef const Args __attribute__((address_space(4))) CArgs;
    gu32* ctl; { CArgs* ap0 = (CArgs*)__builtin_amdgcn_kernarg_segment_ptr(); ctl = (gu32*)(ap0->ws + WS_CTL); }
    for (int u = threadIdx.x; u < (LDS_BYTES - LDSCTL_OFF) / 4; u += NTHR) ((LAS unsigned*)(lds + LDSCTL_OFF))[u] = 0u;
    __syncthreads();
    if (!MK_SPLIT) (void)xcd_barrier_post((unsigned*)(ctl + CW_BAR), MISC + 8);
#define GRID_BAR() do { if (MK_SPLIT) { } else { CArgs* apb = (CArgs*)__builtin_amdgcn_kernarg_segment_ptr(); asm volatile("" : "+s"(apb)); XcdBarrier bar_; \
        bar_.bar = (unsigned*)(apb->ws + WS_CTL) + CW_BAR; bar_.x = xb_xcc_id(); bar_.st = (volatile LAS unsigned*)(lds + MISC_OFF) + 8; xcd_barrier(bar_); } } while (0)
    int lo, hi; { CArgs* ap0 = (CArgs*)__builtin_amdgcn_kernarg_segment_ptr(); lo = ap0->ph_lo; hi = ap0->ph_hi; }
#define IN(k) (lo <= (k) && (k) < hi)
#define BOTH(k) (IN(k) && IN((k) + 1))

#define PA() CArgs* ap = (CArgs*)__builtin_amdgcn_kernarg_segment_ptr(); asm volatile("" : "+s"(ap)); unsigned char* const ws = ap->ws; float* const X = (float*)(ws + WS_X); \
    bf16* const WinT = (bf16*)(ws + WS_WIN); bf16* const WbT = (bf16*)(ws + WS_WB); bf16* const WoT = (bf16*)(ws + WS_WO); \
    bf16* const XN = (bf16*)(ws + WS_XN); bf16* const BR = (bf16*)(ws + WS_BR); bf16* const H2 = (bf16*)(ws + WS_H2); bf16* const Hb = (bf16*)(ws + WS_H); \
    float* const Ub = (float*)(ws + WS_U); bf16* const SBb = (bf16*)(ws + WS_SB); \
    (void)X; (void)WinT; (void)WbT; (void)WoT; (void)XN; (void)BR; (void)H2; (void)Hb; (void)Ub; (void)SBb

    if (IN(0)) {
        LT(); PA();
        LAS float* scr = (LAS float*)(lds + wave * 16384);
        constexpr int I_IN = 32 * 160, I_B = 4 * 8 * 64, I_O = 32 * 64, I_L = I_IN + I_B + I_O;
        for (int it = bx; it < DEPTH * 320; it += G) {
            const int l = it / 320, j = it - l * 320; const bool gate = j >= 64;
            const int n0 = gate ? C_GL + (j - 64) * 32 : (int)((0xD962u >> (4 * (j >> 4))) & 15u) * 512 + (j & 15) * 32;
            quantw_item(ap->in[7] + (size_t)l * DM * HP, n0, ap->in[6] + (size_t)l * DM, (signed char*)(ws + WS_WIN) + ((size_t)l * HP + NBF) * DM * 2, (float*)(ws + WS_SW) + l * NQ,
                        gate, gate ? n0 - C_GL : in_pos(n0) - NBF, (LAS float*)lds, tid); }
        {
            constexpr int NIT = DEPTH * I_L;
            auto t_load = [&](int it, float (&w)[32], float& g, int& fl, bf16*& dst) {
                const int l = it / I_L; int r = it - l * I_L; const float* src; const float* gq; int ldw;
                if (r < I_IN) { const int kb = r / 160, pos0 = (r - kb * 160) * 32;
                    const int n0 = (int)((0xA7310548CBULL >> (4 * (pos0 >> 9))) & 15ULL) * 512 + (pos0 & 511);
                    src = ap->in[7] + ((size_t)l * DM + kb * 64) * HP + n0; ldw = HP; dst = WinT + ((size_t)l * HP + pos0) * DM + kb * 64; gq = ap->in[6] + (size_t)l * DM + kb * 64; fl = 1; }
                else if (r < I_IN + I_B) { r -= I_IN; const int i = r >> 9, rr = r & 511, kb = rr >> 6, nb = rr & 63;
                    src = ap->in[8] + (((size_t)l * 4 + i) * 512 + kb * 64) * DM + nb * 32; ldw = DM; dst = WbT + ((size_t)l * DM + nb * 32) * DM + i * 512 + kb * 64; gq = ap->in[6]; fl = 0; }
                else { r -= I_IN + I_B; const int kb = r >> 6, nb = r & 63;
                    src = ap->in[9] + ((size_t)l * DM + kb * 64) * DM + nb * 32; ldw = DM; dst = WoT + ((size_t)l * DM + nb * 32) * DM + kb * 64; gq = ap->in[6]; fl = 0; }
                const float* sp = src + (size_t)(lane >> 5) * ldw + (lane & 31);
#pragma unroll
                for (int i = 0; i < 32; ++i) w[i] = __builtin_nontemporal_load(sp + (size_t)(2 * i) * ldw);
                g = gq[lane];
            };
            auto t_proc = [&](const float (&w)[32], float g0, int fl, bf16* dst) {
#pragma unroll
                for (int i = 0; i < 32; ++i) scr[(2 * i + (lane >> 5)) * 33 + (lane & 31)] = w[i];
                const float g = fl ? g0 : 1.f; const int c = lane & 7; float gk[8];
#pragma unroll
                for (int e = 0; e < 8; ++e) gk[e] = __shfl(g, 8 * c + e);
                asm volatile("s_waitcnt lgkmcnt(0)" ::: "memory");
#pragma unroll
                for (int j = 0; j < 4; ++j) { const int n = (lane >> 3) + 8 * j; const LAS float* sq = scr + (8 * c) * 33 + n;
                    u32x4 o; o.x = pk2(sq[0 * 33] * gk[0], sq[1 * 33] * gk[1]); o.y = pk2(sq[2 * 33] * gk[2], sq[3 * 33] * gk[3]);
                    o.z = pk2(sq[4 * 33] * gk[4], sq[5 * 33] * gk[5]); o.w = pk2(sq[6 * 33] * gk[6], sq[7 * 33] * gk[7]);
                    *(u32x4*)(dst + (size_t)n * DM + 8 * c) = o; }
                asm volatile("s_waitcnt lgkmcnt(0)" ::: "memory");
            };
            float wa[32], wb[32], ga, gb; int fa, fb; bf16* da; bf16* db;
            int it = gw;
            if (it < NIT) {
                t_load(it, wa, ga, fa, da);
                while (true) {
                    const int i1 = it + NGW; const bool m1 = i1 < NIT;
                    t_load(m1 ? i1 : it, wb, gb, fb, db); __builtin_amdgcn_sched_barrier(0);
                    t_proc(wa, ga, fa, da);
                    if (!m1) break;
                    const int i2 = i1 + NGW; const bool m2 = i2 < NIT;
                    t_load(m2 ? i2 : i1, wa, ga, fa, da); __builtin_amdgcn_sched_barrier(0);
                    t_proc(wb, gb, fb, db);
                    if (!m2) break;
                    it = i2;
                }
            }
        }
        {
            auto x_load = [&](int m, f32x4 (&v)[8]) {
                const float* src = (m < MP) ? ap->in[0] + (size_t)m * DM : ap->in[1] + (size_t)(m - MP) * DM;
                const f32x4* xr = (const f32x4*)src + lane;
#pragma unroll
                for (int j = 0; j < 8; ++j) v[j] = __builtin_nontemporal_load(xr + 64 * j);
            };
            auto x_proc = [&](int m, const f32x4 (&v)[8]) {
                float sq = 0.f, am = 0.f;
#pragma unroll
                for (int j = 0; j < 8; ++j) { sq += (v[j].x * v[j].x + v[j].y * v[j].y) + (v[j].z * v[j].z + v[j].w * v[j].w);
                    am = fmaxf(fmaxf(am, fmaxf(fabsf(v[j].x), fabsf(v[j].y))), fmaxf(fabsf(v[j].z), fabsf(v[j].w))); }
                const float tot = wave_sum(sq); am = wave_max(am);
                const float inv = am > 0.f ? 127.f / am : 0.f;
                if (lane == 0) { ((float*)(ws + WS_CTL) + CW_SSQ)[m] = tot; ((float*)(ws + WS_RS))[m] = __builtin_amdgcn_rsqf(tot * (1.f / DM) + NORM_EPS) * am * (1.f / 127.f); }
                unsigned* xq = (unsigned*)((signed char*)(ws + WS_XQ) + (size_t)m * DM) + lane; u32x2* xn = (u32x2*)(XN + (size_t)m * DM) + lane;
#pragma unroll
                for (int j = 0; j < 8; ++j) { xq[64 * j] = pack_i8x4(v[j].x * inv, v[j].y * inv, v[j].z * inv, v[j].w * inv);
                    u32x2 o; o.x = pk2(v[j].x, v[j].y); o.y = pk2(v[j].z, v[j].w); xn[64 * j] = o; }
            };
            f32x4 va[8], vb[8];
            int m = gw;
            if (m < MT) {
                x_load(m, va);
                while (true) {
                    const int m1 = m + NGW; const bool k1 = m1 < MT;
                    x_load(k1 ? m1 : m, vb); __builtin_amdgcn_sched_barrier(0);
                    x_proc(m, va);
                    if (!k1) break;
                    const int m2 = m1 + NGW; const bool k2 = m2 < MT;
                    x_load(k2 ? m2 : m1, va); __builtin_amdgcn_sched_barrier(0);
                    x_proc(m1, vb);
                    if (!k2) break;
                    m = m2;
                }
            }
        }
        if (BOTH(0)) GRID_BAR();
    }

#define LL() int ll = l; asm volatile("" : "+s"(ll))
#define MKMA() LL(); PA(); MixArgs MA; \
        MA.H = Hb; MA.BR = BR; MA.out = ap->out; MA.U = Ub; MA.SB = SBb; MA.l = ll; \
        MA.state_ret = ap->in[2] + (size_t)ll * DB * 4 * 64 * 128; MA.state_conv = ap->in[3] + (size_t)ll * DB * 2 * 512; \
        MA.cache_k = ap->in[4] + (size_t)ll * DB * 512 * 512; MA.cache_v = ap->in[5] + (size_t)ll * DB * 512 * 512; \
        MA.conv_w = ap->in[10] + (size_t)ll * 3 * 512; MA.ln_g = ap->in[11] + (size_t)ll * 512; MA.ln_b = ap->in[12] + (size_t)ll * 512; \
        MA.gws = ap->in[13] + (size_t)ll * 4 * 128 * 128; MA.gbs = ap->in[14] + (size_t)ll * 4 * 128; MA.relb = ap->in[15] + (size_t)ll * 8 * 257
    for (int l = 0; l < DEPTH; ++l) {
        const int p = 2 + 7 * l;
        if (IN(p)) {
            LL(); PA();
            { pg8::Gemm g{XN, WinT + (size_t)ll * HP * DM, DM * 2, 0}; pg8::SegOrder S; S.init(MP, NBF, G, bx, 1, DM / 64);
              pg8::EpiH E{Hb, (const float*)(ws + WS_CTL) + CW_SSQ + (size_t)ll * MT};
              pg8::gemm_phase<pg8::EpiH, pg8::SegOrder, true, true>(lds, g, S, E); }
            { pg8::Gemm g{ws + WS_XQ, ws + WS_WIN + ((size_t)ll * HP + NBF) * DM * 2, DM, 0}; pg8::SegOrder S; S.init(MP, NQ, G, bx, 1, DM / 128);
              pg8::EpiHqT<false> E{Hb, (const float*)(ws + WS_RS) + (size_t)ll * MT, (const float*)(ws + WS_SW) + ll * NQ, (bf16*)(ws + WS_RB)};
              pg8::gemm_phase<pg8::EpiHqT<false>, pg8::SegOrder, true, true, true>(lds, g, S, E); }
            if (BOTH(p)) GRID_BAR();
        }
        if (IN(p + 1)) {
            MKMA();
            if (bx < 120) {
                const int spn = bx % 60;
                if (spn < NBF / 256) { pg8::Gemm g{XN, WinT + (size_t)ll * HP * DM, DM * 2, 0}; pg8::OneUnit S{MP / 256 + bx / 60, spn, 0, DM / 64};
                    pg8::EpiH E{Hb, (const float*)(ws + WS_CTL) + CW_SSQ + (size_t)ll * MT};
                    pg8::gemm_phase<pg8::EpiH, pg8::OneUnit, true, true>(lds, g, S, E); }
                else { pg8::Gemm g{ws + WS_XQ, ws + WS_WIN + ((size_t)ll * HP + NBF) * DM * 2, DM, 0}; pg8::OneUnit S{MP / 256 + bx / 60, spn - NBF / 256, 0, DM / 128};
                    pg8::EpiHqT<true> E{Hb, (const float*)(ws + WS_RS) + (size_t)ll * MT, (const float*)(ws + WS_SW) + ll * NQ, (bf16*)(ws + WS_RB)};
                    pg8::gemm_phase<pg8::EpiHqT<true>, pg8::OneUnit, true, true, true>(lds, g, S, E); }
            }
            if (bx < 120 && bx % 60 >= NBF / 256) {
                int u = (bx < 60) ? bx - NBF / 256 : bx - 60 - NBF / 256 + (60 - NBF / 256); asm volatile("" : "+s"(u));
                if (u < 64) { LT(); conv_prompt_unit(MA, u, tid); } }
            { unsigned* qc = (unsigned*)(ws + WS_CTL) + CW_Q + 64 * ll; LAS int* qs = (LAS int*)(lds + LDS_BYTES - 64);
              int qraw = 0;
              auto issue = [&]() { if (threadIdx.x == 0) qraw = (int)xb_add(qc, 1u); };
              auto take = [&]() -> int { if (threadIdx.x == 0) *qs = qraw; __syncthreads(); return __builtin_amdgcn_readfirstlane(*qs); };
              int q, qn;
              { int r0 = 0, r1 = 0; if (threadIdx.x == 0) { r0 = (int)xb_add(qc, 1u); r1 = (int)xb_add(qc, 1u); if (r1 < r0) { const int t = r0; r0 = r1; r1 = t; } qs[0] = r0; qs[1] = r1; }
                __syncthreads(); q = __builtin_amdgcn_readfirstlane(qs[0]); qn = __builtin_amdgcn_readfirstlane(qs[1]); __syncthreads(); }
              while (q < 1024) { issue();
                  if (q < 512) { LT(); attn_prompt_unit(MA, q, lds, tid, lane, wave); }
                  else { LT(); gmlp_prompt_unit(MA, q - 512, lds, tid, lane, wave); }
                  q = qn; qn = take(); }
              if (q < 2048) { LT(); RuLd L; ru_load(MA, q - 1024, tid, L);
                  while (q < 2048) { issue(); ret_u_unit(MA, q - 1024, (qn < 2048) ? qn - 1024 : -1, L, lds, tid, lane, wave); q = qn; qn = take(); } } }
            if (BOTH(p + 1)) GRID_BAR();
        }
        if (IN(p + 2)) {
            MKMA();
            { LT(); for (int it = bx * NTHR + tid; it < 32 * 4096; it += G * NTHR) ret_prefix_item(MA, it); }
            for (int u = bx; u < 256; u += G) { LT(); attn_sample_unit(MA, u, lds, tid, lane, wave); }
            for (int u = bx; u < 128; u += G) { LT(); ret_sample_unit(MA, u, lds, tid); }
            for (int u = G - 1 - bx; u < 32; u += G) { LT(); convgmlp_sample_unit(MA, u, lds, tid, lane, wave); }
            if (bx >= 128 && bx < 224) {
                for (int k = 0; k < 2; ++k) { int u = 64 + 2 * (bx - 128) + k; asm volatile("" : "+s"(u)); LT(); conv_prompt_unit(MA, u, tid); } }
            __syncthreads();
            if (BOTH(p + 2)) GRID_BAR();
        }
        if (IN(p + 3)) {
            MKMA();
#define KV_BLOCKS(B0, PER) { for (int k0 = 0; k0 < (PER); k0 += 4) { u32x4 kvv[4]; \
                _Pragma("unroll") for (int k = 0; k < 4; ++k) { const int blk = (B0) + k0 + k; kvv[k] = kv_copy_load(MA, ((blk < 1024) ? blk : 1023) * NTHR + tid); } \
                _Pragma("unroll") for (int k = 0; k < 4; ++k) { const int blk = (B0) + k0 + k; if (k0 + k < (PER) && blk < 1024) kv_copy_store(MA, blk * NTHR + tid, kvv[k]); } } }
            const int nonG = G - 64, lim = (5 * nonG < 1024) ? 5 * nonG : 1024;
            if (bx >= nonG) {
                const int q = bx - nonG, t16 = q >> 2;
                pg8::Gemm g{BR, WbT + (size_t)ll * DM * DM, DM * 2, 1024}; pg8::OneUnit S{MP / 256 + (t16 >> 3), t16 & 7, q & 3, 8};
                pg8::EpiMergeS E{Hb, (float*)(ws + WS_MP)};
                pg8::gemm_phase<pg8::EpiMergeS, pg8::OneUnit, true, true>(lds, g, S, E);
                for (int u0 = lim + q; u0 < 1024; u0 += 64) { int u = u0; asm volatile("" : "+s"(u)); LT(); RoLd L; ro_load(MA, u, tid, L); ret_out_unit(MA, u, -1, L, lds, tid, lane, wave); }
                { LT(); KV_BLOCKS(2 * q, 2) }
            } else {
                { LT(); RoLd L; ro_load(MA, bx, tid, L);
                  for (int u = bx; u < lim; u += nonG) ret_out_unit(MA, u, (u + nonG < lim) ? u + nonG : -1, L, lds, tid, lane, wave); }
                { LT(); const int per = (1024 - 128 + nonG - 1) / nonG; KV_BLOCKS(128 + bx * per, per) }
            }
#undef KV_BLOCKS
            __syncthreads();
            if (BOTH(p + 3)) GRID_BAR();
        }
        if (IN(p + 4)) {
            LL(); PA();
            { LT(); const float* mp = (const float*)(ws + WS_MP);
              for (int it = bx * NTHR + tid; it < MS * DM / 8; it += G * NTHR) { const size_t e = (size_t)it * 8;
                  f32x4 a = *(const f32x4*)(mp + e), b = *(const f32x4*)(mp + e + 4);
#pragma unroll
                  for (int q = 1; q < 4; ++q) { a += *(const f32x4*)(mp + (size_t)q * MS * DM + e); b += *(const f32x4*)(mp + (size_t)q * MS * DM + e + 4); }
                  u32x4 w; w.x = pk2(a.x, a.y); w.y = pk2(a.z, a.w); w.z = pk2(b.x, b.y); w.w = pk2(b.z, b.w);
                  *(u32x4*)(H2 + (size_t)MP * DM + e) = w; } }
            pg8::Gemm g{BR, WbT + (size_t)ll * DM * DM, DM * 2, 1024}; pg8::SegOrder S; S.init(MP, DM, G, bx, 4, 8);
            pg8::EpiMerge E{(const bf16*)(ws + WS_RB), H2};
            pg8::gemm_phase<pg8::EpiMerge, pg8::SegOrder, true, true>(lds, g, S, E);
            if (BOTH(p + 4)) GRID_BAR();
        }
        if (IN(p + 5)) {
            LL(); PA();
            pg8::Gemm g{H2, WoT + (size_t)ll * DM * DM, DM * 2, 512}; pg8::OutOrder S; S.P.init(MP, DM, G, bx, 1, DM / 64); S.nP = (MP / 256) * (DM / 256) / G; S.c = bx;
            const bool fuse = (ll < DEPTH - 1);
            (void)fuse; pg8::EpiOut E{XN, (float*)(ws + WS_XP), nullptr};
            pg8::gemm_phase<pg8::EpiOut, pg8::OutOrder, true, true>(lds, g, S, E);
            if (BOTH(p + 5)) GRID_BAR();
        }
        if (IN(p + 6)) {
            LT(); LL(); PA();
            const float* XPb = (const float*)(ws + WS_XP);
#define PIPE2(LOAD, PROC) { u32x4 ta[4], tb[4]; int m = gw; if (m < MP) { LOAD(m, ta); while (true) { \
                const int m1 = m + NGW; const bool k1 = m1 < MP; LOAD(k1 ? m1 : m, tb); __builtin_amdgcn_sched_barrier(0); PROC(m, ta); if (!k1) break; \
                const int m2 = m1 + NGW; const bool k2 = m2 < MP; LOAD(k2 ? m2 : m1, ta); __builtin_amdgcn_sched_barrier(0); PROC(m1, tb); if (!k2) break; m = m2; } } }
            auto n_load = [&](int m, u32x4 (&t)[4]) { const bf16* src = XN + (size_t)m * DM + lane * 8;
#pragma unroll
                for (int j = 0; j < 4; ++j) t[j] = *(const u32x4*)(src + 512 * j); };
            if (ll < DEPTH - 1) {
                auto n_mid = [&](int m, const u32x4 (&t)[4]) {
                    f32x4 v[4][2]; float sq = 0.f, am = 0.f;
#pragma unroll
                    for (int j = 0; j < 4; ++j) { v[j][0] = (f32x4){bflo(t[j].x), bfhi(t[j].x), bflo(t[j].y), bfhi(t[j].y)}; v[j][1] = (f32x4){bflo(t[j].z), bfhi(t[j].z), bflo(t[j].w), bfhi(t[j].w)};
#pragma unroll
                        for (int hf = 0; hf < 2; ++hf) { const f32x4 a = v[j][hf]; sq += (a.x * a.x + a.y * a.y) + (a.z * a.z + a.w * a.w);
                            am = fmaxf(fmaxf(am, fmaxf(fabsf(a.x), fabsf(a.y))), fmaxf(fabsf(a.z), fabsf(a.w))); } }
                    const float tot = wave_sum(sq); am = wave_max(am);
                    const float inv = am > 0.f ? 127.f / am : 0.f;
                    if (lane == 0) { ((float*)(ws + WS_CTL) + CW_SSQ + (size_t)(ll + 1) * MT)[m] = tot; ((float*)(ws + WS_RS) + (size_t)(ll + 1) * MT)[m] = __builtin_amdgcn_rsqf(tot * (1.f / DM) + NORM_EPS) * am * (1.f / 127.f); }
                    signed char* xq = (signed char*)(ws + WS_XQ) + (size_t)m * DM + lane * 8;
#pragma unroll
                    for (int j = 0; j < 4; ++j) *(u32x2*)(xq + 512 * j) = (u32x2){pack_i8x4(v[j][0].x * inv, v[j][0].y * inv, v[j][0].z * inv, v[j][0].w * inv), pack_i8x4(v[j][1].x * inv, v[j][1].y * inv, v[j][1].z * inv, v[j][1].w * inv)};
                };
                PIPE2(n_load, n_mid)
                for (int m = MP + gw; m < MT; m += NGW)
                    norm_row_bf(XN + (size_t)m * DM, XN + (size_t)m * DM, nullptr, nullptr, lane, XPb + (size_t)(m - MP) * DM, (float*)(ws + WS_CTL) + CW_SSQ + (size_t)(ll + 1) * MT + m,
                                (signed char*)(ws + WS_XQ) + (size_t)m * DM, (float*)(ws + WS_RS) + (size_t)(ll + 1) * MT + m);
            } else {
                f32x4 gn[4][2];
#pragma unroll
                for (int j = 0; j < 4; ++j) { gn[j][0] = *(const f32x4*)(ap->in[16] + lane * 8 + 512 * j); gn[j][1] = *(const f32x4*)(ap->in[16] + lane * 8 + 512 * j + 4); }
                auto n_fin = [&](int m, const u32x4 (&t)[4]) {
                    f32x4 v[4][2]; float sq = 0.f;
#pragma unroll
                    for (int j = 0; j < 4; ++j) { v[j][0] = (f32x4){bflo(t[j].x), bfhi(t[j].x), bflo(t[j].y), bfhi(t[j].y)}; v[j][1] = (f32x4){bflo(t[j].z), bfhi(t[j].z), bflo(t[j].w), bfhi(t[j].w)};
#pragma unroll
                        for (int hf = 0; hf < 2; ++hf) { const f32x4 a = v[j][hf]; sq += (a.x * a.x + a.y * a.y) + (a.z * a.z + a.w * a.w); } }
                    const float rstd = __builtin_amdgcn_rsqf(wave_sum(sq) * (1.f / DM) + NORM_EPS);
                    float* op = ap->out + (size_t)m * DM + lane * 8;
#pragma unroll
                    for (int j = 0; j < 4; ++j) { *(f32x4*)(op + 512 * j) = v[j][0] * rstd * gn[j][0]; *(f32x4*)(op + 512 * j + 4) = v[j][1] * rstd * gn[j][1]; }
                };
                PIPE2(n_load, n_fin)
                for (int m = MP + gw; m < MT; m += NGW) norm_row_bf(XN + (size_t)m * DM, nullptr, ap->out + (size_t)m * DM, ap->in[16], lane, XPb + (size_t)(m - MP) * DM, nullptr);
            }
#undef PIPE2
            if (BOTH(p + 6)) GRID_BAR();
        }
    }
#undef IN
#undef BOTH
}

extern "C" void kernel_launch(void* const* d_in, const int* in_sizes, int n_in, void* d_out, int out_size, void* d_ws, size_t ws_size, hipStream_t stream) {
    static int grid = 0;
    if (grid == 0) {
        if (n_in != 17 || (size_t)out_size != O_END || ws_size < WS_END) { fprintf(stderr, "kernel_launch: unexpected sizes: n_in %d out %d ws %zu (need %zu)\n", n_in, out_size, ws_size, (size_t)WS_END); grid = -1; return; }
        int dev = 0, cus = 0, per_cu = 0;
        if (hipGetDevice(&dev) != hipSuccess || hipDeviceGetAttribute(&cus, hipDeviceAttributeMultiprocessorCount, dev) != hipSuccess) { grid = -1; return; }
        if (hipFuncSetAttribute((const void*)enc_fwd, hipFuncAttributeMaxDynamicSharedMemorySize, LDS_BYTES) != hipSuccess) { fprintf(stderr, "kernel_launch: hipFuncSetAttribute failed\n"); grid = -1; return; }
        if (hipOccupancyMaxActiveBlocksPerMultiprocessor(&per_cu, (const void*)enc_fwd, NTHR, LDS_BYTES) != hipSuccess || per_cu < 1) { fprintf(stderr, "kernel_launch: occupancy query says %d\n", per_cu); }
        (void)hipGetLastError();
        grid = cus;
        if (grid < 128) { fprintf(stderr, "kernel_launch: built for a >= 128-CU device (got %d)\n", grid); grid = -1; return; }
    }
    if (grid < 0) return;
    if (hipMemsetAsync((char*)d_ws + WS_CTL, 0, CTL_ZERO_BYTES, stream) != hipSuccess) return;
    Args a{};
    for (int i = 0; i < 17; ++i) a.in[i] = (const float*)d_in[i];
    a.out = (float*)d_out; a.ws = (unsigned char*)d_ws;
#if MK_SPLIT
    for (int ph = 0; ph < N_PHASES; ++ph) { a.ph_lo = ph; a.ph_hi = ph + 1; hipLaunchKernelGGL(enc_fwd, dim3(grid), dim3(NTHR), LDS_BYTES, stream, a); }
#else
    a.ph_lo = 0; a.ph_hi = N_PHASES;
    hipLaunchKernelGGL(enc_fwd, dim3(grid), dim3(NTHR), LDS_BYTES, stream, a);
#endif
}
```
